# Optimizing an MI355X kernel written in HIP

```python
import jax, jax.numpy as jnp
from jax import lax
import numpy as np

D_MODEL = 1024
BATCH = 2
SEQ = 16384
DEPTH = 4

N_MIXERS = 2
N_A_LAYERS = (DEPTH + 1) // 2
N_B_LAYERS = DEPTH // 2
RMS_EPS = 1e-6
NEG_INF = -1e30

A_GROUPS = ((128, 1), (512, 4), (2048, 16))
A_N_GROUPS = len(A_GROUPS)
A_HEADS = 16
A_HEAD_DIM = D_MODEL // A_HEADS
A_WIDTH = A_HEADS * A_HEAD_DIM
A_IN_WIDTH = A_N_GROUPS * 3 * A_WIDTH
ROPE_THETA = 10000.0

B_HEADS = 4
B_KEY_DIM = D_MODEL // 2 // B_HEADS
B_VAL_DIM = D_MODEL // B_HEADS
B_QK_WIDTH = B_HEADS * B_KEY_DIM
B_V_WIDTH = B_HEADS * B_VAL_DIM
B_GATE_RANK = 16
B_GATE_TAU = 16.0
B_CHUNK = 64
B_IN_WIDTH = 2 * B_QK_WIDTH + 2 * B_V_WIDTH + 2 * B_GATE_RANK

FFN_HIDDEN = -(-8 * D_MODEL // (3 * 256)) * 256

kernel_name = "hybrid_dilated_attn_gla_encoder"


def rms_norm(x, gain):
    xf = x.astype(jnp.float32)
    y = xf * lax.rsqrt(jnp.mean(xf * xf, axis=-1, keepdims=True) + RMS_EPS)
    return (y * gain.astype(jnp.float32)).astype(x.dtype)


def rope(x, positions):
    half = x.shape[-1] // 2
    inv_freq = ROPE_THETA ** (-jnp.arange(half, dtype=jnp.float32) / half)
    ang = positions.astype(jnp.float32)[:, None] * inv_freq[None, :]
    cos = jnp.cos(ang)[:, None, :]
    sin = jnp.sin(ang)[:, None, :]
    xf = x.astype(jnp.float32)
    x1, x2 = xf[..., :half], xf[..., half:]
    return jnp.concatenate([x1 * cos - x2 * sin, x2 * cos + x1 * sin], axis=-1).astype(x.dtype)


def dilated_window_attention(q, k, v, window, dilation):
    bsz, seq, nh, dh = q.shape
    half = window // (2 * dilation)
    L = seq // dilation
    nb = -(-L // half)
    Lp = nb * half

    def to_phase(t):
        t = t.reshape(bsz, L, dilation, nh, dh)
        return jnp.moveaxis(t, 2, 1).reshape(bsz * dilation, L, nh, dh)

    n = bsz * dilation
    qp = jnp.pad(to_phase(q), ((0, 0), (0, Lp - L), (0, 0), (0, 0))).reshape(n, nb, half, nh, dh)

    def key_blocks(t):
        t = jnp.pad(to_phase(t), ((0, 0), (half, Lp - L + half), (0, 0), (0, 0)))
        t = t.reshape(n, nb + 2, half, nh, dh)
        return jnp.concatenate([t[:, :-2], t[:, 1:-1], t[:, 2:]], axis=2)

    kb = key_blocks(k)
    vb = key_blocks(v)
    tq = jnp.arange(nb)[:, None] * half + jnp.arange(half)[None, :]
    tk = jnp.arange(nb)[:, None] * half + jnp.arange(3 * half)[None, :] - half
    dist = tk[:, None, :] - tq[:, :, None]
    valid = (tk[:, None, :] >= 0) & (tk[:, None, :] < L) & (jnp.abs(dist) <= half)

    scores = jnp.einsum("nbqhd,nbkhd->nbhqk", qp.astype(jnp.float32), kb.astype(jnp.float32)) * (dh ** -0.5)
    scores = jnp.where(valid[None, :, None], scores, NEG_INF)
    m = jnp.max(scores, axis=-1, keepdims=True)
    p = jnp.exp(scores - m)
    l = jnp.sum(p, axis=-1)
    o = jnp.einsum("nbhqk,nbkhd->nbqhd", p, vb.astype(jnp.float32))
    o = o / jnp.moveaxis(l, 2, 3)[..., None]
    lse = jnp.moveaxis(m[..., 0] + jnp.log(l), 2, 3)

    def from_phase(t):
        rest = t.shape[4:]
        t = t.reshape(bsz, dilation, Lp, nh, *rest)[:, :, :L]
        return jnp.moveaxis(t, 1, 2).reshape(bsz, seq, nh, *rest)

    return from_phase(o), from_phase(lse)


def dilated_attention_mixer(h, w_in, q_gain, k_gain, w_out, positions):
    bsz, seq, _ = h.shape
    qkv = (h @ w_in).reshape(bsz, seq, A_N_GROUPS, 3, A_HEADS, A_HEAD_DIM)
    outs, lses = [], []
    for g, (window, dilation) in enumerate(A_GROUPS):
        q = rope(rms_norm(qkv[:, :, g, 0], q_gain[g]), positions)
        k = rope(rms_norm(qkv[:, :, g, 1], k_gain[g]), positions)
        v = qkv[:, :, g, 2]
        o, lse = dilated_window_attention(q, k, v, window, dilation)
        outs.append(o)
        lses.append(lse)
    alpha = jax.nn.softmax(jnp.stack(lses, axis=0), axis=0)
    out = jnp.sum(alpha[..., None] * jnp.stack(outs, axis=0), axis=0)
    return out.reshape(bsz, seq, A_WIDTH).astype(h.dtype) @ w_out


def gla_chunk(q, k, v, log_a, strict):
    bsz, nh, seq, dk = q.shape
    dv = v.shape[-1]
    nc = seq // B_CHUNK
    q = q.astype(jnp.float32).reshape(bsz, nh, nc, B_CHUNK, dk)
    k = k.astype(jnp.float32).reshape(bsz, nh, nc, B_CHUNK, dk)
    v = v.astype(jnp.float32).reshape(bsz, nh, nc, B_CHUNK, dv)
    b = jnp.cumsum(log_a.astype(jnp.float32).reshape(bsz, nh, nc, B_CHUNK, dk), axis=3)
    b_last = b[..., -1:, :]
    q_t = q * jnp.exp(b)
    k_t = k * jnp.exp(-b)
    k_end = k * jnp.exp(b_last - b)
    mask = jnp.tril(jnp.ones((B_CHUNK, B_CHUNK), dtype=bool), k=-1 if strict else 0)
    attn = jnp.where(mask, jnp.einsum("bhncd,bhnsd->bhncs", q_t, k_t), 0.0)
    o_intra = jnp.einsum("bhncs,bhnse->bhnce", attn, v)
    chunk_kv = jnp.einsum("bhncd,bhnce->bhnde", k_end, v)
    decay = jnp.exp(b_last[..., 0, :])

    def step(state, inp):
        kv_n, dec_n = inp
        return dec_n[..., None] * state + kv_n, state

    init = jnp.zeros((bsz, nh, dk, dv), jnp.float32)
    _, s_in = lax.scan(step, init, (jnp.moveaxis(chunk_kv, 2, 0), jnp.moveaxis(decay, 2, 0)))
    s_in = jnp.moveaxis(s_in, 0, 2)
    o_inter = jnp.einsum("bhncd,bhnde->bhnce", q_t, s_in)
    return (o_intra + o_inter).reshape(bsz, nh, seq, dv)


def _heads(t, nh):
    bsz, seq, _ = t.shape
    return t.reshape(bsz, seq, nh, -1).transpose(0, 2, 1, 3)


def gla_mixer(h, w_in, w_gate_f, bias_gate_f, w_gate_b, bias_gate_b, out_gain, w_out):
    bsz, seq, _ = h.shape
    proj = h @ w_in
    cuts = np.cumsum([B_QK_WIDTH, B_QK_WIDTH, B_V_WIDTH, B_V_WIDTH, B_GATE_RANK]).tolist()
    q, k, v, r, zf, zb = jnp.split(proj, cuts, axis=-1)
    q = _heads(q, B_HEADS) * (B_KEY_DIM ** -0.5)
    k = _heads(k, B_HEADS)
    v = _heads(v, B_HEADS)
    log_af = jax.nn.log_sigmoid((zf @ w_gate_f + bias_gate_f).astype(jnp.float32)) / B_GATE_TAU
    log_ab = jax.nn.log_sigmoid((zb @ w_gate_b + bias_gate_b).astype(jnp.float32)) / B_GATE_TAU
    log_af = _heads(log_af, B_HEADS)
    log_ab = _heads(log_ab, B_HEADS)
    o_f = gla_chunk(q, k, v, log_af, strict=False)
    flip = lambda t: jnp.flip(t, axis=2)
    o_b = flip(gla_chunk(flip(q), flip(k), flip(v), flip(log_ab), strict=True))
    o = (o_f + o_b).transpose(0, 2, 1, 3)
    o = rms_norm(o, out_gain).reshape(bsz, seq, B_V_WIDTH)
    o = o * jax.nn.silu(r.astype(jnp.float32))
    return o.astype(h.dtype) @ w_out


def swiglu(h, w_gate_up, w_down):
    g, u = jnp.split(h @ w_gate_up, 2, axis=-1)
    return (jax.nn.silu(g) * u) @ w_down


def setup_inputs(seed: int = 0) -> dict:
    key = jax.random.key(seed)
    ks = jax.random.split(key, 16)

    def nrm(k, shape, scale):
        return jax.random.normal(k, shape, jnp.float32) * scale

    return {
        "x": nrm(ks[0], (BATCH, SEQ, D_MODEL), 1.0),
        "attn_norm": 1.0 + nrm(ks[1], (DEPTH, D_MODEL), 0.02),
        "ffn_norm": 1.0 + nrm(ks[2], (DEPTH, D_MODEL), 0.02),
        "a_w_in": nrm(ks[3], (N_A_LAYERS, D_MODEL, A_IN_WIDTH), D_MODEL ** -0.5),
        "a_q_norm": 1.0 + nrm(ks[4], (N_A_LAYERS, A_N_GROUPS, A_HEAD_DIM), 0.02),
        "a_k_norm": 1.0 + nrm(ks[5], (N_A_LAYERS, A_N_GROUPS, A_HEAD_DIM), 0.02),
        "a_w_out": nrm(ks[6], (N_A_LAYERS, A_WIDTH, D_MODEL), A_WIDTH ** -0.5),
        "b_w_in": nrm(ks[7], (N_B_LAYERS, D_MODEL, B_IN_WIDTH), D_MODEL ** -0.5),
        "b_w_gate_f": nrm(ks[8], (N_B_LAYERS, B_GATE_RANK, B_QK_WIDTH), B_GATE_RANK ** -0.5),
        "b_gate_bias_f": nrm(ks[9], (N_B_LAYERS, B_QK_WIDTH), 0.1),
        "b_w_gate_b": nrm(ks[10], (N_B_LAYERS, B_GATE_RANK, B_QK_WIDTH), B_GATE_RANK ** -0.5),
        "b_gate_bias_b": nrm(ks[11], (N_B_LAYERS, B_QK_WIDTH), 0.1),
        "b_out_norm": 1.0 + nrm(ks[12], (N_B_LAYERS, B_HEADS, B_VAL_DIM), 0.02),
        "b_w_out": nrm(ks[13], (N_B_LAYERS, B_V_WIDTH, D_MODEL), B_V_WIDTH ** -0.5),
        "ffn_w_gate_up": nrm(ks[14], (DEPTH, D_MODEL, 2 * FFN_HIDDEN), D_MODEL ** -0.5),
        "ffn_w_down": nrm(ks[15], (DEPTH, FFN_HIDDEN, D_MODEL), FFN_HIDDEN ** -0.5),
    }


def reference(x, attn_norm, ffn_norm, a_w_in, a_q_norm, a_k_norm, a_w_out, b_w_in, b_w_gate_f, b_gate_bias_f, b_w_gate_b, b_gate_bias_b, b_out_norm, b_w_out, ffn_w_gate_up, ffn_w_down):
    positions = jnp.arange(x.shape[1])
    h = x
    for i in range(DEPTH):
        j = i // N_MIXERS
        hn = rms_norm(h, attn_norm[i])
        if i % N_MIXERS == 0:
            mix = dilated_attention_mixer(hn, a_w_in[j], a_q_norm[j], a_k_norm[j], a_w_out[j], positions)
        else:
            mix = gla_mixer(hn, b_w_in[j], b_w_gate_f[j], b_gate_bias_f[j], b_w_gate_b[j], b_gate_bias_b[j], b_out_norm[j], b_w_out[j])
        h = h + mix.astype(h.dtype)
        h = h + swiglu(rms_norm(h, ffn_norm[i]), ffn_w_gate_up[i], ffn_w_down[i]).astype(h.dtype)
    return h
```

```cpp
#include <hip/hip_runtime.h>
#include <hip/hip_cooperative_groups.h>
#include <cstdio>
#include <cstdint>
namespace cg = cooperative_groups;

#define DI __device__ __forceinline__
#define LAS __attribute__((address_space(3)))
typedef unsigned short bf16_t;
typedef short bf16x8 __attribute__((ext_vector_type(8)));
typedef short s16x4 __attribute__((ext_vector_type(4)));
typedef float f32x4 __attribute__((ext_vector_type(4)));
typedef unsigned u32x4 __attribute__((ext_vector_type(4)));
typedef unsigned u32x2 __attribute__((ext_vector_type(2)));

constexpr int T_TOK = 32768, S_LEN = 16384, DM = 1024, FFN_H = 2816;
constexpr float EPS = 1e-6f;
constexpr float LOG2E = 1.4426950408889634f;
constexpr int NPHASES = 31;
constexpr int LDS_BYTES = 155648;
constexpr int NSEG = 32, CPS = 8;

constexpr size_t MiB = 1048576;
constexpr size_t OFF_SS = 0, SS_BYTES = 2 * MiB, OFF_COS = 4 * MiB, OFF_SIN = 6 * MiB, OFF_LSE = 8 * MiB, OFF_Z = 9 * MiB, OFF_DSEG = 13 * MiB, OFF_DEC = 14 * MiB;
constexpr size_t OFF_W0 = 16 * MiB, W_BYTES = 37 * MiB, OFF_HB = 90 * MiB, OFF_R = 154 * MiB;
constexpr size_t OFF_QKV = OFF_R, OFF_AOUT = OFF_R + 288 * MiB;
constexpr size_t OFF_PROJ = OFF_R, OFF_GATED = OFF_R + 192 * MiB, OFF_STATE = OFF_R + 256 * MiB;
constexpr size_t OFF_ACT = OFF_R;
constexpr size_t WS_NEED = 506 * MiB;
constexpr size_t OFF_BAR = OFF_DSEG + 512 * 1024;
constexpr size_t W_IN = 0, W_OUT = 9437184, W_GU = 10485760, W_DN = 16252928;

struct Params {
  const float* in[16];
  float* out;
  unsigned char* ws;
  int ph_lo, ph_hi;
};

DI float bf2f(bf16_t v) { return __uint_as_float(((unsigned)v) << 16); }
DI unsigned cvt_pk(float lo, float hi) { unsigned r; asm("v_cvt_pk_bf16_f32 %0, %1, %2" : "=v"(r) : "v"(lo), "v"(hi)); return r; }
DI bf16_t f2bf(float f) { return (bf16_t)(cvt_pk(f, 0.f) & 0xffffu); }
DI float fast_exp2(float x) { return __builtin_amdgcn_exp2f(x); }
DI float fast_log2(float x) { return __builtin_amdgcn_logf(x); }
DI float fast_rcp(float x) { return __builtin_amdgcn_rcpf(x); }
DI float fast_exp(float x) { return __builtin_amdgcn_exp2f(x * LOG2E); }
DI int otid() { int t = threadIdx.x; asm volatile("" : "+v"(t)); return t; }
DI float row_rstd(const float* ssp, size_t row) {
  const f32x4 a = *(const f32x4*)(ssp + row * 16), b = *(const f32x4*)(ssp + row * 16 + 4), c = *(const f32x4*)(ssp + row * 16 + 8), d = *(const f32x4*)(ssp + row * 16 + 12);
  const float s = (((a[0] + a[1]) + (a[2] + a[3])) + ((b[0] + b[1]) + (b[2] + b[3]))) + (((c[0] + c[1]) + (c[2] + c[3])) + ((d[0] + d[1]) + (d[2] + d[3])));
  return rsqrtf(s * (1.0f / 1024.0f) + 1e-6f);
}
DI int perm32(int p) { return 8 * ((p & 15) >> 2) + 4 * (p >> 4) + (p & 3); }
DI f32x4 mfma16(bf16x8 a, bf16x8 b, f32x4 c) { return __builtin_amdgcn_mfma_f32_16x16x32_bf16(a, b, c, 0, 0, 0); }
DI bf16x8 tr_pair(LAS unsigned char* p0, LAS unsigned char* p1) {
  s16x4 a = __builtin_amdgcn_ds_read_tr16_b64_v4i16((LAS s16x4*)p0);
  s16x4 b = __builtin_amdgcn_ds_read_tr16_b64_v4i16((LAS s16x4*)p1);
  bf16x8 f; f[0] = a[0]; f[1] = a[1]; f[2] = a[2]; f[3] = a[3]; f[4] = b[0]; f[5] = b[1]; f[6] = b[2]; f[7] = b[3];
  return f;
}

constexpr int BM = 256, BK = 64, HALF = 128;
DI int lds_byte(int r, int c) { int st = (r >> 4) * 2 + (c >> 5), rr = r & 15, cc = c & 31, ob = rr * 64 + cc * 2; return st * 1024 + (ob ^ (((ob >> 9) & 1) << 5)); }
DI void stage_rc(int b, int& R, int& C) { int st = b / 1024, sb = b % 1024, swz = sb ^ (((sb >> 9) & 1) << 5); R = (st >> 1) * 16 + swz / 64; C = (st & 1) * 32 + (swz % 64) / 2; }

#define G_SA(b, h) (((b) * 2 + (h)) * 16384)
#define G_SB(b, h) ((4 + (b) * 2 + (h)) * 16384)
#define G_STAGE(PO, BASE, br, kt) do { const bf16_t* _g = (BASE) + (long)(br) * K + (long)(kt) * BK; \
    _Pragma("unroll") for (int _i = 0; _i < 2; ++_i) \
      __builtin_amdgcn_global_load_lds((const unsigned*)(_g + soff[_i]), (LAS unsigned*)(lds + (PO) + tid * 16 + _i * 8192), 16, 0, 0); } while (0)
#define G_LDA(dst, b, h) do { _Pragma("unroll") for (int m = 0; m < 4; ++m) _Pragma("unroll") for (int k = 0; k < 2; ++k) \
    dst[m][k] = *(const LAS bf16x8*)(lds + G_SA(b, h) + aoff + m * 2048 + k * 1024); } while (0)
#define G_LDB(dst, b, h) do { _Pragma("unroll") for (int n = 0; n < 2; ++n) _Pragma("unroll") for (int k = 0; k < 2; ++k) \
    dst[n][k] = *(const LAS bf16x8*)(lds + G_SB(b, h) + boff + n * 2048 + k * 1024); } while (0)
#define G_MMA(ai, bj, At_, Bt_) do { __builtin_amdgcn_s_setprio(1); \
    _Pragma("unroll") for (int m = 0; m < 4; ++m) _Pragma("unroll") for (int n = 0; n < 2; ++n) _Pragma("unroll") for (int k = 0; k < 2; ++k) \
      acc[ai][bj][m][n] = __builtin_amdgcn_mfma_f32_16x16x32_bf16(Bt_[n][k], At_[m][k], acc[ai][bj][m][n], 0, 0, 0); \
    __builtin_amdgcn_s_setprio(0); } while (0)
#define WAIT_V(n) asm volatile("s_waitcnt vmcnt(" #n ")" ::: "memory")
#define WAIT_L(n) asm volatile("s_waitcnt lgkmcnt(" #n ")" ::: "memory")
#define BAR __builtin_amdgcn_s_barrier()
#define SCHED __builtin_amdgcn_sched_barrier(0)
#define LBAR_ do { asm volatile("s_waitcnt lgkmcnt(0)" ::: "memory"); __builtin_amdgcn_s_barrier(); asm volatile("" ::: "memory"); } while (0)

DI float rstd_of(const f32x4 s) { return rsqrtf(((s[0] + s[1]) + (s[2] + s[3])) * (1.0f / 1024.0f) + 1e-6f); }
template <class Epi>
DI void gemm_tile(LAS unsigned char* lds, const bf16_t* __restrict__ A, const bf16_t* __restrict__ Bt, const int K,
                  const int pm, const int pn, const Epi& epi, const bool first, const bool have_next, const int npm, const int npn) {
  const int tid = otid();
  const int wid = tid >> 6, lane = tid & 63, wr = wid >> 2, wc = wid & 3, fr = lane & 15, fq = lane >> 4;
  const int brow = pm * BM, bcol = pn * BM;
  long soff[2];
  { int r_, c_; stage_rc(tid * 16, r_, c_); soff[0] = (long)r_ * K + c_; stage_rc(tid * 16 + 8192, r_, c_); soff[1] = (long)r_ * K + c_; }
  const int aoff = lds_byte(wr * 64 + fr, fq * 8), boff = lds_byte(wc * 32 + fr, fq * 8);
  f32x4 acc[2][2][4][2];
#pragma unroll
  for (int a = 0; a < 2; ++a)
#pragma unroll
    for (int b = 0; b < 2; ++b)
#pragma unroll
      for (int m = 0; m < 4; ++m)
#pragma unroll
        for (int n = 0; n < 2; ++n) acc[a][b][m][n] = (f32x4){0.f, 0.f, 0.f, 0.f};
  bf16x8 At[4][2], B0[2][2], B1[2][2];
  const int nt = K / BK;
  if (first) {
    __syncthreads();
    G_STAGE(G_SB(0, 0), Bt, bcol, 0); G_STAGE(G_SA(0, 0), A, brow, 0);
    G_STAGE(G_SB(0, 1), Bt, bcol + HALF, 0); G_STAGE(G_SA(0, 1), A, brow + HALF, 0);
  }
  f32x4 svr = (f32x4){0.f, 0.f, 0.f, 0.f};
  if constexpr (Epi::RSTD) svr = *(const f32x4*)(epi.ss + (size_t)(brow + (tid & 255)) * 4);
  f32x4 pr0 = svr, pr1 = svr; float prg = 0.f;
  if constexpr (Epi::ROPE) epi.pre_load(pr0, pr1, prg, brow, pn, tid);
  if (wr == 1) BAR;
  WAIT_V(0); BAR;
  if constexpr (Epi::RSTD) ((LAS float*)(lds + 135168))[tid & 255] = rstd_of(svr);
  if constexpr (Epi::ROPE) epi.pre_store(lds, pr0, pr1, prg, tid);
  G_STAGE(G_SB(1, 0), Bt, bcol, 1); G_STAGE(G_SA(1, 0), A, brow, 1); G_STAGE(G_SB(1, 1), Bt, bcol + HALF, 1);
  WAIT_V(6); BAR;
  for (int t = 0; t < nt - 2; t += 2) {
    G_LDB(B0, 0, 0); SCHED; G_LDA(At, 0, 0); G_STAGE(G_SA(1, 1), A, brow + HALF, t + 1);
    WAIT_L(8); BAR; WAIT_L(0); G_MMA(0, 0, At, B0); BAR; SCHED;
    G_LDB(B1, 0, 1); G_STAGE(G_SB(0, 0), Bt, bcol, t + 2);
    BAR; WAIT_L(0); G_MMA(0, 1, At, B1); BAR;
    G_LDA(At, 0, 1); G_STAGE(G_SA(0, 0), A, brow, t + 2);
    BAR; WAIT_L(0); G_MMA(1, 0, At, B0); BAR; SCHED;
    G_STAGE(G_SB(0, 1), Bt, bcol + HALF, t + 2);
    WAIT_V(6); BAR; G_MMA(1, 1, At, B1); BAR;
    G_LDB(B0, 1, 0); SCHED; G_LDA(At, 1, 0); G_STAGE(G_SA(0, 1), A, brow + HALF, t + 2);
    WAIT_L(8); BAR; WAIT_L(0); G_MMA(0, 0, At, B0); BAR; SCHED;
    G_LDB(B1, 1, 1); G_STAGE(G_SB(1, 0), Bt, bcol, t + 3);
    BAR; WAIT_L(0); G_MMA(0, 1, At, B1); BAR;
    G_LDA(At, 1, 1); G_STAGE(G_SA(1, 0), A, brow, t + 3);
    BAR; WAIT_L(0); G_MMA(1, 0, At, B0); BAR; SCHED;
    G_STAGE(G_SB(1, 1), Bt, bcol + HALF, t + 3);
    WAIT_V(6); BAR; G_MMA(1, 1, At, B1); BAR;
  }
  { G_LDB(B0, 0, 0); G_LDA(At, 0, 0); G_STAGE(G_SA(1, 1), A, brow + HALF, nt - 1);
    BAR; WAIT_L(0); G_MMA(0, 0, At, B0); BAR;
    G_LDB(B1, 0, 1); BAR; WAIT_L(0); G_MMA(0, 1, At, B1); BAR;
    G_LDA(At, 0, 1); WAIT_V(4); BAR; WAIT_L(0); G_MMA(1, 0, At, B0); G_MMA(1, 1, At, B1); BAR; }
  { G_LDB(B0, 1, 0); G_LDA(At, 1, 0); WAIT_V(2); BAR;
    if (have_next) {
      const int nbrow = npm * BM, nbcol = npn * BM;
      G_STAGE(G_SB(0, 0), Bt, nbcol, 0); G_STAGE(G_SA(0, 0), A, nbrow, 0);
      G_STAGE(G_SB(0, 1), Bt, nbcol + HALF, 0); G_STAGE(G_SA(0, 1), A, nbrow + HALF, 0);
    }
    WAIT_L(0); G_MMA(0, 0, At, B0); BAR;
    G_LDB(B1, 1, 1); if (have_next) { WAIT_V(8); } else { WAIT_V(0); } BAR; WAIT_L(0); G_MMA(0, 1, At, B1); BAR;
    G_LDA(At, 1, 1); BAR; WAIT_L(0); G_MMA(1, 0, At, B0); G_MMA(1, 1, At, B1); BAR; }
  if (wr == 0) BAR;
  epi(lds, acc, pm, pn, wr, wc, fr, fq);
}

DI bool gemm_unit(int i, int nM, int nN, int& pm, int& pn) {
  const int nwg = nM * nN;
  const long L = (long)i * gridDim.x + blockIdx.x;
  if (L >= nwg) return false;
  int wgid = (int)L;
  { const int q = nwg / 8, r = nwg % 8, xcd = wgid % 8, off = wgid / 8; wgid = (xcd < r ? xcd * (q + 1) : r * (q + 1) + (xcd - r) * q) + off; }
  const int nig = 8 * nN, gid = wgid / nig, fm = gid * 8, gsz = (nM - fm) < 8 ? (nM - fm) : 8;
  pm = fm + ((wgid % nig) % gsz); pn = (wgid % nig) / gsz;
  return true;
}
template <class Epi>
DI void gemm_phase(LAS unsigned char* lds, const bf16_t* A, const bf16_t* Bt, int M, int N, int K, const Epi& epi) {
  const int nM = M / BM, nN = N / BM;
  int pm, pn;
  if (!gemm_unit(0, nM, nN, pm, pn)) return;
  for (int i = 0;; ++i) {
    int npm = 0, npn = 0;
    const bool have_next = gemm_unit(i + 1, nM, nN, npm, npn);
    gemm_tile(lds, A, Bt, K, pm, pn, epi, i == 0, have_next, npm, npn);
    if (!have_next) break;
    pm = npm; pn = npn;
  }
}

#define EPI_FENCE asm volatile("" ::: "memory")
constexpr int EQ_GN = 136192, EQ_CS = 136448, EQ_CSS = 272;
struct EpiQKV {
  static constexpr bool RSTD = true, ROPE = true;
  bf16_t* qkv; const float* ss; const float* qg; const float* kg; const float* cosT; const float* sinT;
  DI void pre_load(f32x4& r0, f32x4& r1, float& g, int brow, int pn, int tid) const {
    const int type = (pn % 12) >> 2, gi = pn / 12;
    const int c = 2 * tid, tr = c >> 4, q = c & 15;
    const size_t s = (size_t)(brow + (tr >> 5) * 64 + (tr & 31));
    const float* src = (q < 8) ? (cosT + s * 32 + 4 * q) : (sinT + s * 32 + 4 * (q - 8));
    r0 = *(const f32x4*)src; r1 = *(const f32x4*)(src + 4);
    g = ((type == 0) ? qg : kg)[gi * 64 + (tid & 63)];
  }
  DI void pre_store(LAS unsigned char* lds, const f32x4& r0, const f32x4& r1, float g, int tid) const {
    const int c = 2 * tid, tr = c >> 4, q = c & 15;
    *(LAS f32x4*)(lds + EQ_CS + tr * EQ_CSS + q * 16) = r0;
    *(LAS f32x4*)(lds + EQ_CS + tr * EQ_CSS + q * 16 + 16) = r1;
    if (tid < 64) ((LAS float*)(lds + EQ_GN))[tid] = g;
  }
  DI void operator()(LAS unsigned char* lds, f32x4 (&acc)[2][2][4][2], int pm, int pn, int wr, int wc, int fr, int fq) const {
    const int g = pn / 12, type = (pn % 12) >> 2, head = (pn & 3) * 4 + wc;
    bf16_t* base = qkv + (size_t)((g * 3 + type) * 16 + head) * S_LEN * 64;
    const float* gp = (type == 0 ? qg : kg) + g * 64;
    const int s0 = pm * BM + wr * 64 + fr;
    float rstd[2][4];
#pragma unroll
    for (int ai = 0; ai < 2; ++ai)
#pragma unroll
      for (int m = 0; m < 4; ++m) rstd[ai][m] = ((const LAS float*)(lds + 135168))[ai * HALF + wr * 64 + m * 16 + fr];
    f32x4 g1[2], g2[2];
    if (type < 2) {
#pragma unroll
      for (int n = 0; n < 2; ++n) { g1[n] = *(const LAS f32x4*)(lds + EQ_GN + (8 * fq + 4 * n) * 4); g2[n] = *(const LAS f32x4*)(lds + EQ_GN + (32 + 8 * fq + 4 * n) * 4); }
    }
#pragma unroll
    for (int aim = 0; aim < 4; ++aim) {
      const int ai = aim >> 1, mb = (aim & 1) * 2;
      f32x4 cs[4][2], sn[4][2];
      if (type < 2) {
#pragma unroll
        for (int m = mb; m < mb + 2; ++m)
#pragma unroll
          for (int n = 0; n < 2; ++n) {
            if (aim == 0) {
              const int tr = wr * 32 + m * 16 + fr;
              cs[m][n] = *(const LAS f32x4*)(lds + EQ_CS + tr * EQ_CSS + (8 * fq + 4 * n) * 4);
              sn[m][n] = *(const LAS f32x4*)(lds + EQ_CS + tr * EQ_CSS + 128 + (8 * fq + 4 * n) * 4);
            } else {
              const size_t o = (size_t)(s0 + ai * HALF + m * 16) * 32 + 8 * fq + 4 * n;
              cs[m][n] = *(const f32x4*)(cosT + o); sn[m][n] = *(const f32x4*)(sinT + o);
            }
          }
      }
      EPI_FENCE;
#pragma unroll
      for (int m = mb; m < mb + 2; ++m) {
        const int s = s0 + ai * HALF + m * 16;
        f32x4 v[2][2];
#pragma unroll
        for (int bj = 0; bj < 2; ++bj)
#pragma unroll
          for (int n = 0; n < 2; ++n) v[bj][n] = acc[ai][bj][m][n] * rstd[ai][m];
        if (type < 2) {
          float q = 0.f;
#pragma unroll
          for (int bj = 0; bj < 2; ++bj)
#pragma unroll
            for (int n = 0; n < 2; ++n) q += v[bj][n][0] * v[bj][n][0] + v[bj][n][1] * v[bj][n][1] + v[bj][n][2] * v[bj][n][2] + v[bj][n][3] * v[bj][n][3];
          q += __shfl_xor(q, 16); q += __shfl_xor(q, 32);
          float rn = rsqrtf(q * (1.0f / 64.0f) + EPS);
          if (type == 0) rn *= 0.125f * LOG2E;
#pragma unroll
          for (int n = 0; n < 2; ++n) {
            const f32x4 x1 = v[0][n] * g1[n] * rn, x2 = v[1][n] * g2[n] * rn;
            v[0][n] = x1 * cs[m][n] - x2 * sn[m][n]; v[1][n] = x2 * cs[m][n] + x1 * sn[m][n];
          }
        }
        bf16_t* rp = base + (size_t)s * 64 + 8 * fq;
#pragma unroll
        for (int bj = 0; bj < 2; ++bj) {
          u32x4 w; w.x = cvt_pk(v[bj][0][0], v[bj][0][1]); w.y = cvt_pk(v[bj][0][2], v[bj][0][3]); w.z = cvt_pk(v[bj][1][0], v[bj][1][1]); w.w = cvt_pk(v[bj][1][2], v[bj][1][3]);
          *(u32x4*)(rp + bj * 32) = w;
        }
      }
      EPI_FENCE;
    }
  }
};
struct EpiRes {
  static constexpr bool RSTD = false, ROPE = false;
  const float* resid; float* hout; bf16_t* hb; float* ssn;
  DI void operator()(LAS unsigned char* lds, f32x4 (&acc)[2][2][4][2], int pm, int pn, int wr, int wc, int fr, int fq) const {
    const size_t base0 = (size_t)(pm * BM + wr * 64 + fr) * DM + pn * BM + wc * 32 + fq * 4;
    LAS float* red = (LAS float*)(lds + 131072);
#pragma unroll
    for (int ai = 0; ai < 2; ++ai) {
      f32x4 rv[4][2][2];
#pragma unroll
      for (int m = 0; m < 4; ++m)
#pragma unroll
        for (int bj = 0; bj < 2; ++bj)
#pragma unroll
          for (int n = 0; n < 2; ++n) rv[m][bj][n] = *(const f32x4*)(resid + base0 + (size_t)(ai * HALF + m * 16) * DM + bj * HALF + n * 16);
      EPI_FENCE;
#pragma unroll
      for (int m = 0; m < 4; ++m) {
        const size_t off0 = base0 + (size_t)(ai * HALF + m * 16) * DM;
        float* op = hout + off0; bf16_t* bp = hb + off0;
        float q = 0.f;
#pragma unroll
        for (int bj = 0; bj < 2; ++bj)
#pragma unroll
          for (int n = 0; n < 2; ++n) {
            const f32x4 o = rv[m][bj][n] + acc[ai][bj][m][n];
            *(f32x4*)(op + bj * HALF + n * 16) = o;
            q += o[0] * o[0] + o[1] * o[1] + o[2] * o[2] + o[3] * o[3];
            u32x2 w; w.x = cvt_pk(o[0], o[1]); w.y = cvt_pk(o[2], o[3]);
            *(u32x2*)(bp + bj * HALF + n * 16) = w;
          }
        q += __shfl_xor(q, 16); q += __shfl_xor(q, 32);
        if (fq == 0) red[(ai * HALF + wr * 64 + m * 16 + fr) * 4 + wc] = q;
      }
      EPI_FENCE;
    }
    LBAR_;
    if (ssn) {
      const int t = threadIdx.x;
      if (t < 256) { const f32x4 p = *(const LAS f32x4*)(red + t * 4); ssn[(size_t)(pm * BM + t) * 4 + pn] = (p[0] + p[1]) + (p[2] + p[3]); }
    }
  }
};
struct EpiSwiglu {
  static constexpr bool RSTD = true, ROPE = false;
  bf16_t* act; const float* ss;
  DI void operator()(LAS unsigned char* lds, f32x4 (&acc)[2][2][4][2], int pm, int pn, int wr, int wc, int fr, int fq) const {
    const size_t r0 = (size_t)(pm * BM + wr * 64 + fr);
#pragma unroll
    for (int ai = 0; ai < 2; ++ai)
#pragma unroll
      for (int m = 0; m < 4; ++m) {
        const size_t row = r0 + ai * HALF + m * 16;
        const float rstd = ((const LAS float*)(lds + 135168))[ai * HALF + wr * 64 + m * 16 + fr];
        float o[8];
#pragma unroll
        for (int n = 0; n < 2; ++n)
#pragma unroll
          for (int j = 0; j < 4; ++j) {
            const float gg = acc[ai][0][m][n][j] * rstd, uu = acc[ai][1][m][n][j] * rstd;
            o[n * 4 + j] = gg * fast_rcp(1.0f + fast_exp(-gg)) * uu;
          }
        u32x4 w; w.x = cvt_pk(o[0], o[1]); w.y = cvt_pk(o[2], o[3]); w.z = cvt_pk(o[4], o[5]); w.w = cvt_pk(o[6], o[7]);
        *(u32x4*)(act + row * FFN_H + pn * 128 + wc * 32 + 8 * fq) = w;
      }
  }
};
struct EpiProj {
  static constexpr bool RSTD = true, ROPE = false;
  bf16_t* proj; float* zbuf; const float* ss;
  DI void operator()(LAS unsigned char* lds, f32x4 (&acc)[2][2][4][2], int pm, int pn, int wr, int wc, int fr, int fq) const {
    const size_t r0 = (size_t)(pm * BM + wr * 64 + fr);
#pragma unroll
    for (int ai = 0; ai < 2; ++ai)
#pragma unroll
      for (int m = 0; m < 4; ++m) {
        const size_t row = r0 + ai * HALF + m * 16;
        const float rstd = ((const LAS float*)(lds + 135168))[ai * HALF + wr * 64 + m * 16 + fr];
        if (pn < 12) {
#pragma unroll
          for (int bj = 0; bj < 2; ++bj) {
            const f32x4 a = acc[ai][bj][m][0] * rstd, b = acc[ai][bj][m][1] * rstd;
            u32x4 w; w.x = cvt_pk(a[0], a[1]); w.y = cvt_pk(a[2], a[3]); w.z = cvt_pk(b[0], b[1]); w.w = cvt_pk(b[2], b[3]);
            *(u32x4*)(proj + row * 3072 + pn * BM + bj * HALF + wc * 32 + 8 * fq) = w;
          }
        } else if (wc == 0) {
          *(f32x4*)(zbuf + row * 32 + 8 * fq) = acc[ai][0][m][0] * rstd;
          *(f32x4*)(zbuf + row * 32 + 8 * fq + 4) = acc[ai][0][m][1] * rstd;
        }
      }
  }
};

struct ConvJob { const float* src; bf16_t* dst; const float* gain; int K, Nsrc, Ndst, mode; };
DI void conv_tile(LAS unsigned char* lds, const ConvJob& J, int t) {
  LAS float* tile = (LAS float*)lds;
  const int tid = otid();
  const int nkt = J.K / 64, nt_ = t / nkt, kt = t % nkt;
  const int nn = tid & 255, np = nt_ * 256 + nn;
  int src; float cs = 1.f;
  if (J.mode == 0) src = np;
  else if (J.mode == 1) { const int r = np & 255; src = (np & ~255) + ((r >> 5) & 3) * 64 + (r >> 7) * 32 + perm32(r & 31); }
  else if (J.mode == 2) { const int r = np & 255; src = (r >> 7) * FFN_H + (np >> 8) * 128 + ((r >> 5) & 3) * 32 + perm32(r & 31); }
  else { src = (np & ~31) + perm32(np & 31); if (src < 512) cs = 0.08838834764831845f; if (src >= 3104) src = -1; }
  float v[32];
#pragma unroll
  for (int e = 0; e < 32; ++e) {
    const int k = kt * 64 + (tid >> 8) + 2 * e;
    v[e] = (src >= 0) ? J.src[(size_t)k * J.Nsrc + src] : 0.f;
  }
  if (J.gain) {
#pragma unroll
    for (int e = 0; e < 32; ++e) v[e] *= J.gain[kt * 64 + (tid >> 8) + 2 * e];
  }
  __syncthreads();
#pragma unroll
  for (int e = 0; e < 32; ++e) tile[((tid >> 8) + 2 * e) * 257 + nn] = v[e] * cs;
  __syncthreads();
#pragma unroll
  for (int p = 0; p < 4; ++p) {
    const int n2 = (tid >> 3) + 64 * p, kc = tid & 7;
    float f[8];
#pragma unroll
    for (int j = 0; j < 8; ++j) f[j] = tile[(kc * 8 + j) * 257 + n2];
    u32x4 w; w.x = cvt_pk(f[0], f[1]); w.y = cvt_pk(f[2], f[3]); w.z = cvt_pk(f[4], f[5]); w.w = cvt_pk(f[6], f[7]);
    *(u32x4*)(J.dst + (size_t)(nt_ * 256 + n2) * J.K + kt * 64 + kc * 8) = w;
  }
}
DI void convert_layer(const Params& P, LAS unsigned char* lds, int li) {
  bf16_t* W = (bf16_t*)(P.ws + OFF_W0 + (size_t)(li & 1) * W_BYTES);
  const int j = li >> 1;
  ConvJob J[4];
  if ((li & 1) == 0) {
    J[0] = ConvJob{P.in[3] + (size_t)j * DM * 9216, W + W_IN, P.in[1] + li * DM, DM, 9216, 9216, 1};
    J[1] = ConvJob{P.in[6] + (size_t)j * DM * DM, W + W_OUT, nullptr, DM, DM, DM, 0};
  } else {
    J[0] = ConvJob{P.in[7] + (size_t)j * DM * 3104, W + W_IN, P.in[1] + li * DM, DM, 3104, 3328, 3};
    J[1] = ConvJob{P.in[13] + (size_t)j * DM * DM, W + W_OUT, nullptr, DM, DM, DM, 0};
  }
  J[2] = ConvJob{P.in[14] + (size_t)li * DM * 2 * FFN_H, W + W_GU, P.in[2] + li * DM, DM, 2 * FFN_H, 2 * FFN_H, 2};
  J[3] = ConvJob{P.in[15] + (size_t)li * FFN_H * DM, W + W_DN, nullptr, FFN_H, DM, DM, 0};
  int cnt[4], tot = 0;
#pragma unroll
  for (int q = 0; q < 4; ++q) { cnt[q] = (J[q].Ndst / 256) * (J[q].K / 64); tot += cnt[q]; }
  for (int t = blockIdx.x; t < tot; t += gridDim.x) {
    int tt = t;
    if (tt < cnt[0]) { conv_tile(lds, J[0], tt); continue; } tt -= cnt[0];
    if (tt < cnt[1]) { conv_tile(lds, J[1], tt); continue; } tt -= cnt[1];
    if (tt < cnt[2]) { conv_tile(lds, J[2], tt); continue; } tt -= cnt[2];
    conv_tile(lds, J[3], tt);
  }
  __syncthreads();
}

DI void prep_phase(const Params& P, LAS unsigned char* lds) {
  const int tid = otid(), wid = tid >> 6, lane = tid & 63;
  const float* x = P.in[0];
  bf16_t* hb = (bf16_t*)(P.ws + OFF_HB);
  float* ss = (float*)(P.ws + OFF_SS);
  for (int row = blockIdx.x * 8 + wid; row < T_TOK; row += gridDim.x * 8) {
    const float* xr = x + (size_t)row * DM;
    float q = 0.f;
#pragma unroll
    for (int e = 0; e < 4; ++e) {
      const f32x4 v = *(const f32x4*)(xr + e * 256 + lane * 4);
      q += v[0] * v[0] + v[1] * v[1] + v[2] * v[2] + v[3] * v[3];
      u32x2 w; w.x = cvt_pk(v[0], v[1]); w.y = cvt_pk(v[2], v[3]);
      *(u32x2*)(hb + (size_t)row * DM + e * 256 + lane * 4) = w;
    }
#pragma unroll
    for (int o = 1; o < 64; o <<= 1) q += __shfl_xor(q, o);
    if (lane < 4) ss[(size_t)row * 4 + lane] = (lane == 0) ? q : 0.f;
  }
  const int gtid = blockIdx.x * 512 + tid, gn = gridDim.x * 512;
  float* cosT = (float*)(P.ws + OFF_COS); float* sinT = (float*)(P.ws + OFF_SIN);
  for (int i = gtid; i < S_LEN * 32; i += gn) {
    const int s = i >> 5, fi = i & 31;
    double f = 1.0;
    for (int k = 0; k < fi; ++k) f *= 0.7498942093324559;
    double rev = (double)s * f * 0.15915494309189535;
    rev -= __builtin_rint(rev);
    cosT[i] = __builtin_amdgcn_cosf((float)rev);
    sinT[i] = __builtin_amdgcn_sinf((float)rev);
  }
  convert_layer(P, lds, 0);
}

constexpr int AT_STR = 144, AT_VOFF = 416 * AT_STR;
#define LBAR do { asm volatile("s_waitcnt lgkmcnt(0)" ::: "memory"); __builtin_amdgcn_s_barrier(); asm volatile("" ::: "memory"); } while (0)
DI void attn_phase(const Params& P, LAS unsigned char* lds, int b) {
  const int tid = otid(), wid = tid >> 6, lane = tid & 63, fr = lane & 15, fq = lane >> 4;
  const bf16_t* qkv = (const bf16_t*)(P.ws + OFF_QKV);
  bf16_t* aout = (bf16_t*)(P.ws + OFF_AOUT) + (size_t)b * S_LEN * DM;
  float* lse = (float*)(P.ws + OFF_LSE);
  __syncthreads();
  for (int i = tid; i < 32 * AT_STR / 4; i += 512) { ((LAS unsigned*)(lds + 384 * AT_STR))[i] = 0u; ((LAS unsigned*)(lds + AT_VOFF + 384 * AT_STR))[i] = 0u; }
  for (int item = blockIdx.x; item < 256; item += gridDim.x) {
    const int tile = item >> 4, head = item & 15, T0 = tile * 1024;
    for (int g = 0; g < 3; ++g) {
      const int lg = 2 * g, dil = 1 << lg, L = S_LEN >> lg;
      const int NP = (g == 2) ? 2 : 1, WR = 384 / NP, NQ = (g < 2) ? 2 : 1, nrounds = (g < 2) ? 4 : 8;
      const bf16_t* Qg = qkv + (size_t)((g * 3 + 0) * 16 + head) * S_LEN * 64;
      const bf16_t* Kg = qkv + (size_t)((g * 3 + 1) * 16 + head) * S_LEN * 64;
      const bf16_t* Vg = qkv + (size_t)((g * 3 + 2) * 16 + head) * S_LEN * 64;
      u32x4 pk[6], pv[6];
#define AT_LOAD(RD) do { int pb_, p0_; if (g == 0) { pb_ = 0; p0_ = T0 + 256 * (RD); } else if (g == 1) { pb_ = (RD); p0_ = T0 >> 2; } else { pb_ = 2 * (RD); p0_ = T0 >> 4; } \
        _Pragma("unroll") for (int e = 0; e < 6; ++e) { const int idx = tid + e * 512, row = idx >> 3, ch = idx & 7; \
          const int slab = (row >= WR) ? 1 : 0, rr = row - slab * WR; const int pos = p0_ - 64 + rr, tok = pos * dil + pb_ + slab; \
          pk[e] = (u32x4){0u, 0u, 0u, 0u}; pv[e] = pk[e]; \
          if (pos >= 0 && pos < L) { pk[e] = *(const u32x4*)(Kg + (size_t)tok * 64 + ch * 8); pv[e] = *(const u32x4*)(Vg + (size_t)tok * 64 + ch * 8); } } } while (0)
      AT_LOAD(0);
      for (int rd = 0; rd < nrounds; ++rd) {
        const int tid = otid(), wid = tid >> 6, lane = tid & 63, fr = lane & 15, fq = lane >> 4;
        int pbase, P0;
        if (g == 0) { pbase = 0; P0 = T0 + 256 * rd; } else if (g == 1) { pbase = rd; P0 = T0 >> 2; } else { pbase = 2 * rd; P0 = T0 >> 4; }
        LBAR;
        if (rd == 0 && g > 0) asm volatile("buffer_inv sc1" ::: "memory");
#pragma unroll
        for (int e = 0; e < 6; ++e) {
          const int idx = tid + e * 512, row = idx >> 3, ch = idx & 7;
          *(LAS u32x4*)(lds + row * AT_STR + ch * 16) = pk[e];
          *(LAS u32x4*)(lds + AT_VOFF + row * AT_STR + ch * 16) = pv[e];
        }
        const int wl = (NP == 2) ? (wid & 3) : wid, slab = (NP == 2) ? (wid >> 2) : 0, phase = pbase + slab;
        const int i0 = P0 + 16 * NQ * wl, rowbase = slab * WR + 16 * NQ * wl;
        bf16x8 qf[2][2]; unsigned long long prev[2][4]; float plse[2];
#pragma unroll
        for (int q = 0; q < 2; ++q) {
          plse[q] = 0.f;
#pragma unroll
          for (int dt = 0; dt < 4; ++dt) prev[q][dt] = 0ull;
          if (q < NQ) {
            const int qtok = (i0 + 16 * q + fr) * dil + phase;
            qf[q][0] = *(const bf16x8*)(Qg + (size_t)qtok * 64 + fq * 8);
            qf[q][1] = *(const bf16x8*)(Qg + (size_t)qtok * 64 + 32 + fq * 8);
            if (g > 0) {
              plse[q] = lse[(size_t)qtok * 16 + head];
#pragma unroll
              for (int dt = 0; dt < 4; ++dt)
                prev[q][dt] = *(const unsigned long long*)(aout + (size_t)qtok * DM + head * 64 + 4 * fq + dt * 16);
            }
          } else { qf[q][0] = (bf16x8){0, 0, 0, 0, 0, 0, 0, 0}; qf[q][1] = qf[q][0]; }
        }
        LBAR;
        if (rd + 1 < nrounds) AT_LOAD(rd + 1);
        LAS unsigned char* kb = lds + (rowbase + fr) * AT_STR + fq * 16;
        LAS unsigned char* vb = lds + AT_VOFF + (rowbase + fq * 4 + (fr >> 2)) * AT_STR + (fr & 3) * 8;
        f32x4 sc[2][9];
        __builtin_amdgcn_s_setprio(1);
#pragma unroll
        for (int t = 0; t < 10; ++t) {
          const bf16x8 k0 = *(const LAS bf16x8*)(kb + t * 16 * AT_STR), k1 = *(const LAS bf16x8*)(kb + t * 16 * AT_STR + 64);
          if (t < 9) { f32x4 a = (f32x4){0.f, 0.f, 0.f, 0.f}; a = mfma16(k0, qf[0][0], a); a = mfma16(k1, qf[0][1], a); sc[0][t] = a; }
          if (t > 0 && NQ == 2) { f32x4 a = (f32x4){0.f, 0.f, 0.f, 0.f}; a = mfma16(k0, qf[1][0], a); a = mfma16(k1, qf[1][1], a); sc[1][t - 1] = a; }
          if (t == 3 || t == 6) SCHED;
        }
        __builtin_amdgcn_s_setprio(0);
        SCHED;
        const bool edge = (i0 < 64) || (i0 + 96 > L);
        float mxv[2], lsv[2];
#pragma unroll
        for (int q = 0; q < 2; ++q) {
          mxv[q] = 0.f; lsv[q] = 1.f;
          if (q < NQ) {
#pragma unroll
            for (int r = 0; r < 4; ++r) {
              if (4 * fq + r < fr) sc[q][0][r] = -3.0e38f;
              if (4 * fq + r > fr) sc[q][8][r] = -3.0e38f;
            }
            if (edge) {
#pragma unroll
              for (int tr = 0; tr < 9; ++tr)
#pragma unroll
                for (int r = 0; r < 4; ++r) { const int kpos = i0 - 64 + (q + tr) * 16 + 4 * fq + r; if (kpos < 0 || kpos >= L) sc[q][tr][r] = -3.0e38f; }
            }
            float mx = -3.0e38f;
#pragma unroll
            for (int tr = 0; tr < 9; ++tr) mx = fmaxf(mx, fmaxf(fmaxf(sc[q][tr][0], sc[q][tr][1]), fmaxf(sc[q][tr][2], sc[q][tr][3])));
            mx = fmaxf(mx, __shfl_xor(mx, 16)); mx = fmaxf(mx, __shfl_xor(mx, 32));
            float lsum = 0.f;
#pragma unroll
            for (int tr = 0; tr < 9; ++tr)
#pragma unroll
              for (int r = 0; r < 4; ++r) { const float p = fast_exp2(sc[q][tr][r] - mx); sc[q][tr][r] = p; lsum += p; }
            lsum += __shfl_xor(lsum, 16); lsum += __shfl_xor(lsum, 32);
            mxv[q] = mx; lsv[q] = lsum;
          }
        }
        f32x4 oacc[2][4];
#pragma unroll
        for (int q = 0; q < 2; ++q)
#pragma unroll
          for (int dt = 0; dt < 4; ++dt) oacc[q][dt] = (f32x4){0.f, 0.f, 0.f, 0.f};
#pragma unroll
        for (int ks = 0; ks < 5; ++ks) {
          bf16x8 pf0, pf1;
          {
            const unsigned a0 = cvt_pk(sc[0][2 * ks][0], sc[0][2 * ks][1]), a1 = cvt_pk(sc[0][2 * ks][2], sc[0][2 * ks][3]);
            unsigned b0 = 0u, b1 = 0u;
            if (ks < 4) { b0 = cvt_pk(sc[0][2 * ks + 1][0], sc[0][2 * ks + 1][1]); b1 = cvt_pk(sc[0][2 * ks + 1][2], sc[0][2 * ks + 1][3]); }
            u32x4 w = (u32x4){a0, a1, b0, b1}; pf0 = *(bf16x8*)&w; }
          pf1 = (bf16x8){0, 0, 0, 0, 0, 0, 0, 0};
          if (NQ == 2) {
            unsigned a0 = 0u, a1 = 0u;
            if (ks > 0) { a0 = cvt_pk(sc[1][2 * ks - 1][0], sc[1][2 * ks - 1][1]); a1 = cvt_pk(sc[1][2 * ks - 1][2], sc[1][2 * ks - 1][3]); }
            const unsigned b0 = cvt_pk(sc[1][2 * ks][0], sc[1][2 * ks][1]), b1 = cvt_pk(sc[1][2 * ks][2], sc[1][2 * ks][3]);
            u32x4 w = (u32x4){a0, a1, b0, b1}; pf1 = *(bf16x8*)&w; }
#pragma unroll
          for (int dt = 0; dt < 4; ++dt) {
            const bf16x8 vf = tr_pair(vb + (ks * 32) * AT_STR + dt * 32, vb + (ks * 32 + 16) * AT_STR + dt * 32);
            oacc[0][dt] = mfma16(vf, pf0, oacc[0][dt]);
            if (NQ == 2) oacc[1][dt] = mfma16(vf, pf1, oacc[1][dt]);
          }
          SCHED;
        }
#pragma unroll
        for (int q = 0; q < 2; ++q) {
          if (q < NQ) {
            const int qtok = (i0 + 16 * q + fr) * dil + phase;
            const float inv = fast_rcp(lsv[q]);
            float l2 = mxv[q] + fast_log2(lsv[q]);
            bf16_t* op = aout + (size_t)qtok * DM + head * 64 + 4 * fq;
            float* lp = lse + (size_t)qtok * 16 + head;
            float w2 = 1.f, w1 = 0.f;
            if (g > 0) {
              const float lr = plse[q];
              const float M = fmaxf(lr, l2);
              const float e1 = fast_exp2(lr - M), e2 = fast_exp2(l2 - M), isum = fast_rcp(e1 + e2);
              w1 = e1 * isum; w2 = e2 * isum; l2 = M + fast_log2(e1 + e2);
            }
#pragma unroll
            for (int dt = 0; dt < 4; ++dt) {
              f32x4 o = oacc[q][dt] * (inv * w2);
              if (g > 0) {
                const unsigned long long pvv = prev[q][dt];
                const unsigned lo = (unsigned)pvv, hi = (unsigned)(pvv >> 32);
                o[0] += w1 * __uint_as_float(lo << 16); o[1] += w1 * __uint_as_float(lo & 0xffff0000u);
                o[2] += w1 * __uint_as_float(hi << 16); o[3] += w1 * __uint_as_float(hi & 0xffff0000u);
              }
              u32x2 w; w.x = cvt_pk(o[0], o[1]); w.y = cvt_pk(o[2], o[3]);
              *(u32x2*)(op + dt * 16) = w;
            }
            if (fq == 0) *lp = l2;
          }
        }
      }
      asm volatile("s_waitcnt vmcnt(0)" ::: "memory");
    }
  }
  __syncthreads();
}

constexpr int GL_ST = 0, GL_STS = 272, GL_V = 69632, GL_VS = 544, GL_Q = GL_V + 64 * GL_VS  , GL_QS = 272, GL_K = GL_Q + 64 * GL_QS  ,
              GL_A = GL_K + 64 * GL_QS  , GL_AS = 144, GL_TOT = GL_A + 64 * GL_AS  , GL_DEC = GL_TOT + 2048, GL_RED = GL_DEC + 512;
static_assert(GL_RED + 2048 <= LDS_BYTES, "lds");

DI float logsig16(float z) { return (fminf(z, 0.f) - __logf(1.0f + __expf(-fabsf(z)))) * (1.0f / 16.0f); }
DI void gla_gate_phase(const Params& P, LAS unsigned char* lds, int lj) {
  const int tid = otid(), h = tid >> 7, dcol = tid & 127, col = h * 128 + dcol;
  bf16_t* proj = (bf16_t*)(P.ws + OFF_PROJ);
  const float* zbuf = (const float*)(P.ws + OFF_Z);
  bf16_t* QB = (bf16_t*)(P.ws + OFF_HB); bf16_t* KB = QB + (size_t)T_TOK * 512;
  float* dect = (float*)(P.ws + OFF_DEC);
  const float* Wf = P.in[8] + (size_t)lj * 16 * 512; const float* Wb = P.in[10] + (size_t)lj * 16 * 512;
  float wf[16], wb[16];
#pragma unroll
  for (int j = 0; j < 16; ++j) { wf[j] = Wf[j * 512 + col]; wb[j] = Wb[j * 512 + col]; }
  const float bf_ = P.in[9][(size_t)lj * 512 + col], bb_ = P.in[11][(size_t)lj * 512 + col];
  LAS float* zL = (LAS float*)lds;
  for (int item = blockIdx.x; item < 512; item += gridDim.x) {
    __syncthreads();
    { const int row = tid >> 3, part = tid & 7; *(LAS f32x4*)(zL + row * 32 + part * 4) = *(const f32x4*)(zbuf + ((size_t)item * 64 + row) * 32 + part * 4); }
    __syncthreads();
    float lsb[64]; float totb = 0.f;
#pragma unroll
    for (int i = 0; i < 64; ++i) {
      float z = bb_;
#pragma unroll
      for (int j4 = 0; j4 < 4; ++j4) { const f32x4 zz = *(const LAS f32x4*)(zL + i * 32 + 16 + j4 * 4); z += zz[0] * wb[j4 * 4] + zz[1] * wb[j4 * 4 + 1] + zz[2] * wb[j4 * 4 + 2] + zz[3] * wb[j4 * 4 + 3]; }
      lsb[i] = logsig16(z); totb += lsb[i];
    }
    float runf = 0.f, runb = 0.f;
#pragma unroll
    for (int ib = 0; ib < 4; ++ib) {
      bf16_t qraw[16], kraw[16];
#pragma unroll
      for (int ii = 0; ii < 16; ++ii) { const bf16_t* pr = proj + ((size_t)item * 64 + ib * 16 + ii) * 3072 + col; qraw[ii] = pr[0]; kraw[ii] = pr[512]; }
      asm volatile("" ::: "memory");
#pragma unroll
      for (int ii = 0; ii < 16; ++ii) {
        const int i = ib * 16 + ii;
        float z = bf_;
#pragma unroll
        for (int j4 = 0; j4 < 4; ++j4) { const f32x4 zz = *(const LAS f32x4*)(zL + i * 32 + j4 * 4); z += zz[0] * wf[j4 * 4] + zz[1] * wf[j4 * 4 + 1] + zz[2] * wf[j4 * 4 + 2] + zz[3] * wf[j4 * 4 + 3]; }
        runf += logsig16(z);
        const float Bi = totb - runb; runb += lsb[i];
        const size_t tokrow = (size_t)item * 64 + i;
        bf16_t* pr = proj + tokrow * 3072 + col;
        const float q = bf2f(qraw[ii]), k = bf2f(kraw[ii]);
        pr[0] = f2bf(q * __expf(runf)); pr[512] = f2bf(k * __expf(-runf));
        QB[tokrow * 512 + col] = f2bf(q * __expf(Bi)); KB[tokrow * 512 + col] = f2bf(k * __expf(-Bi));
      }
      asm volatile("" ::: "memory");
    }
    dect[(size_t)item * 512 + col] = __expf(runf);
    dect[(size_t)(512 + item) * 512 + col] = __expf(totb);
  }
  __syncthreads();
}

template <int MODE>
DI void gla_walk(const Params& P, LAS unsigned char* lds, int lj, int b, int h, int dir, int seg, f32x4 (&accS)[8][2], float& dprod) {
  const bf16_t* proj = (const bf16_t*)(P.ws + OFF_PROJ);
  bf16_t* gated = (bf16_t*)(P.ws + OFF_GATED);
  const float* dect = (const float*)(P.ws + OFF_DEC) + (size_t)dir * 512 * 512 + (size_t)b * 256 * 512 + h * 128;
  const float* ogain = P.in[12] + (size_t)lj * 1024 + h * 256;
  const size_t tokbase = (size_t)b * S_LEN;
  const int qstr = dir ? 512 : 3072;
  const bf16_t* qsrc = (dir ? (const bf16_t*)(P.ws + OFF_HB) + h * 128 : proj + h * 128) + tokbase * qstr;
  const bf16_t* ksrc = (dir ? (const bf16_t*)(P.ws + OFF_HB) + (size_t)T_TOK * 512 + h * 128 : proj + 512 + h * 128) + tokbase * qstr;
  const bf16_t* vsrc = proj + 1024 + h * 256 + tokbase * 3072;
  bf16_t* gbase = gated + tokbase * DM + h * 256;
  const bf16_t* rbase = proj + tokbase * 3072 + 2048 + h * 256;
  LAS float* DEC = (LAS float*)(lds + GL_DEC);
  LAS float* RED = (LAS float*)(lds + GL_RED);
  u32x4 pk[2], pq[2], pv[4]; float pdec = 1.f;
  f32x4 gnv[2];
  { const int t0_ = otid(); gnv[0] = *(const f32x4*)(ogain + (2 * (t0_ >> 6) + 0) * 16 + 4 * ((t0_ & 63) >> 4)); gnv[1] = *(const f32x4*)(ogain + (2 * (t0_ >> 6) + 1) * 16 + 4 * ((t0_ & 63) >> 4)); }
#define GL_LOAD(CC) do { const int t_ = otid(); const int ch_ = dir ? (seg * CPS + CPS - 1 - (CC)) : (seg * CPS + (CC)); const int c0_ = ch_ * 64; \
    _Pragma("unroll") for (int e = 0; e < 2; ++e) { const int idx = t_ + e * 512, i = idx >> 4, cx = idx & 15, tok = dir ? (c0_ + 63 - i) : (c0_ + i); \
      const unsigned o_ = (unsigned)(tok * qstr + cx * 8); pk[e] = *(const u32x4*)(ksrc + o_); if (MODE != 0) pq[e] = *(const u32x4*)(qsrc + o_); } \
    _Pragma("unroll") for (int e = 0; e < 4; ++e) { const int idx = t_ + e * 512, i = idx >> 5, cx = idx & 31, tok = dir ? (c0_ + 63 - i) : (c0_ + i); \
      pv[e] = *(const u32x4*)(vsrc + (unsigned)(tok * 3072 + cx * 8)); } \
    pdec = dect[(size_t)ch_ * 512 + (t_ & 127)]; } while (0)
  GL_LOAD(0);
  for (int cc = 0; cc < CPS; ++cc) {
    const int tid = otid(), wid = tid >> 6, lane = tid & 63, fr = lane & 15, fq = lane >> 4;
    const int c0 = (dir ? (seg * CPS + CPS - 1 - cc) : (seg * CPS + cc)) * 64;
    LBAR;
#pragma unroll
    for (int e = 0; e < 2; ++e) { const int idx = tid + e * 512, i = idx >> 4, cx = idx & 15;
      *(LAS u32x4*)(lds + GL_K + i * GL_QS + cx * 16) = pk[e]; if (MODE != 0) *(LAS u32x4*)(lds + GL_Q + i * GL_QS + cx * 16) = pq[e]; }
#pragma unroll
    for (int e = 0; e < 4; ++e) { const int idx = tid + e * 512, i = idx >> 5, cx = idx & 31; *(LAS u32x4*)(lds + GL_V + i * GL_VS + cx * 16) = pv[e]; }
    if (tid < 128) { DEC[tid] = pdec; dprod *= pdec; }
    LBAR;
    GL_LOAD((cc + 1 < CPS) ? cc + 1 : cc);
    unsigned long long pof[2][4]; u32x2 prv[2][4];
    if (MODE == 2) {
#pragma unroll
      for (int tt = 0; tt < 4; ++tt)
#pragma unroll
        for (int et2 = 0; et2 < 2; ++et2)
          prv[et2][tt] = *(const u32x2*)(rbase + (unsigned)((c0 + 63 - (tt * 16 + fr)) * 3072 + (2 * wid + et2) * 16 + 4 * fq));
#pragma unroll
      for (int tt = 0; tt < 4; ++tt)
#pragma unroll
        for (int et2 = 0; et2 < 2; ++et2)
          pof[et2][tt] = *(const unsigned long long*)(gbase + (unsigned)((c0 + 63 - (tt * 16 + fr)) * DM + (2 * wid + et2) * 16 + 4 * fq));
    }
    if (MODE != 0) {
      const int st = wid >> 1;
#pragma unroll
      for (int t2 = 0; t2 < 2; ++t2) {
        const int tt = 2 * (wid & 1) + t2;
        f32x4 a = (f32x4){0.f, 0.f, 0.f, 0.f};
        if (st <= tt) {
#pragma unroll
          for (int ks = 0; ks < 4; ++ks)
            a = mfma16(*(const LAS bf16x8*)(lds + GL_K + (st * 16 + fr) * GL_QS + ks * 64 + fq * 16),
                       *(const LAS bf16x8*)(lds + GL_Q + (tt * 16 + fr) * GL_QS + ks * 64 + fq * 16), a);
          const int tcol = tt * 16 + fr;
#pragma unroll
          for (int r = 0; r < 4; ++r) { const int s = st * 16 + 4 * fq + r; const bool keep = dir ? (s < tcol) : (s <= tcol); a[r] = keep ? a[r] : 0.f; }
        }
        u32x2 w; w.x = cvt_pk(a[0], a[1]); w.y = cvt_pk(a[2], a[3]);
        *(LAS u32x2*)(lds + GL_A + (tt * 16 + fr) * GL_AS + (st * 16 + 4 * fq) * 2) = w;
      }
      LBAR;
    }
    bf16x8 vf[2][2];
#pragma unroll
    for (int et2 = 0; et2 < 2; ++et2)
#pragma unroll
      for (int ks = 0; ks < 2; ++ks) {
        LAS unsigned char* p = lds + GL_V + (ks * 32 + 8 * fq + (fr >> 2)) * GL_VS + ((2 * wid + et2) * 16 + 4 * (fr & 3)) * 2;
        vf[et2][ks] = tr_pair(p, p + 4 * GL_VS);
      }
    if (MODE != 0) {
      f32x4 accO[2][4];
#pragma unroll
      for (int et2 = 0; et2 < 2; ++et2)
#pragma unroll
        for (int tt = 0; tt < 4; ++tt) accO[et2][tt] = (f32x4){0.f, 0.f, 0.f, 0.f};
#pragma unroll
      for (int tt = 0; tt < 4; ++tt) {
#pragma unroll
        for (int ks = 0; ks < 2; ++ks) {
          const bf16x8 af = *(const LAS bf16x8*)(lds + GL_A + (tt * 16 + fr) * GL_AS + ks * 64 + fq * 16);
          accO[0][tt] = mfma16(vf[0][ks], af, accO[0][tt]);
          accO[1][tt] = mfma16(vf[1][ks], af, accO[1][tt]);
        }
#pragma unroll
        for (int ks = 0; ks < 4; ++ks) {
          const bf16x8 qf = *(const LAS bf16x8*)(lds + GL_Q + (tt * 16 + fr) * GL_QS + ks * 64 + fq * 16);
#pragma unroll
          for (int et2 = 0; et2 < 2; ++et2) {
            const bf16x8 sf = *(const LAS bf16x8*)(lds + GL_ST + ((2 * wid + et2) * 16 + fr) * GL_STS + ks * 64 + fq * 16);
            accO[et2][tt] = mfma16(sf, qf, accO[et2][tt]);
          }
        }
        SCHED;
      }
      if (MODE == 1) {
#pragma unroll
        for (int tt = 0; tt < 4; ++tt) {
          const int t = tt * 16 + fr, tok = c0 + t;
#pragma unroll
          for (int et2 = 0; et2 < 2; ++et2) {
            u32x2 w; w.x = cvt_pk(accO[et2][tt][0], accO[et2][tt][1]); w.y = cvt_pk(accO[et2][tt][2], accO[et2][tt][3]);
            *(u32x2*)(gbase + (unsigned)(tok * DM + (2 * wid + et2) * 16 + 4 * fq)) = w;
          }
        }
      } else {
#pragma unroll
        for (int tt = 0; tt < 4; ++tt) {
          const int t = tt * 16 + fr;
          float q = 0.f;
#pragma unroll
          for (int et2 = 0; et2 < 2; ++et2) {
            const unsigned long long pvv = pof[et2][tt];
            const unsigned lo = (unsigned)pvv, hi = (unsigned)(pvv >> 32);
            f32x4 o = accO[et2][tt];
            o[0] += __uint_as_float(lo << 16); o[1] += __uint_as_float(lo & 0xffff0000u); o[2] += __uint_as_float(hi << 16); o[3] += __uint_as_float(hi & 0xffff0000u);
            accO[et2][tt] = o;
            q += o[0] * o[0] + o[1] * o[1] + o[2] * o[2] + o[3] * o[3];
          }
          q += __shfl_xor(q, 16); q += __shfl_xor(q, 32);
          if (fq == 0) RED[wid * 64 + t] = q;
        }
        LBAR;
#pragma unroll
        for (int tt = 0; tt < 4; ++tt) {
          const int t = tt * 16 + fr, tok = c0 + 63 - t;
          float q = 0.f;
#pragma unroll
          for (int w8 = 0; w8 < 8; ++w8) q += RED[w8 * 64 + t];
          const float rn = rsqrtf(q * (1.0f / 256.0f) + EPS);
#pragma unroll
          for (int et2 = 0; et2 < 2; ++et2) {
            const int e0 = (2 * wid + et2) * 16 + 4 * fq;
            const f32x4 gn = gnv[et2];
            const u32x2 rv = prv[et2][tt];
            float rr[4] = {__uint_as_float(rv.x << 16), __uint_as_float(rv.x & 0xffff0000u), __uint_as_float(rv.y << 16), __uint_as_float(rv.y & 0xffff0000u)};
            float o[4];
#pragma unroll
            for (int r = 0; r < 4; ++r) o[r] = accO[et2][tt][r] * rn * gn[r] * (rr[r] * fast_rcp(1.0f + fast_exp(-rr[r])));
            u32x2 w; w.x = cvt_pk(o[0], o[1]); w.y = cvt_pk(o[2], o[3]);
            *(u32x2*)(gbase + (unsigned)(tok * DM + e0)) = w;
          }
          SCHED;
        }
      }
    }
#pragma unroll
    for (int dt = 0; dt < 8; ++dt) {
#pragma unroll
      for (int ks = 0; ks < 2; ++ks) {
        LAS unsigned char* p = lds + GL_K + (ks * 32 + 8 * fq + (fr >> 2)) * GL_QS + (dt * 16 + 4 * (fr & 3)) * 2;
        const bf16x8 kf = tr_pair(p, p + 4 * GL_QS);
        accS[dt][0] = mfma16(kf, vf[0][ks], accS[dt][0]);
        accS[dt][1] = mfma16(kf, vf[1][ks], accS[dt][1]);
      }
      const f32x4 dc = *(const LAS f32x4*)(lds + GL_DEC + (dt * 16 + 4 * fq) * 4);
#pragma unroll
      for (int et2 = 0; et2 < 2; ++et2) {
        accS[dt][et2] = accS[dt][et2] * dc;
        if (MODE != 0) {
          u32x2 w; w.x = cvt_pk(accS[dt][et2][0], accS[dt][et2][1]); w.y = cvt_pk(accS[dt][et2][2], accS[dt][et2][3]);
          *(LAS u32x2*)(lds + GL_ST + ((2 * wid + et2) * 16 + fr) * GL_STS + (dt * 16 + 4 * fq) * 2) = w;
        }
      }
      if (dt & 1) SCHED;
    }
  }
  LBAR;
}

DI void gla_sum_phase(const Params& P, LAS unsigned char* lds, int lj) {
  const int tid = otid(), wid = tid >> 6, lane = tid & 63;
  float* state = (float*)(P.ws + OFF_STATE);
  float* dseg = (float*)(P.ws + OFF_DSEG);
  __syncthreads();
  for (int item = blockIdx.x; item < 16 * NSEG; item += gridDim.x) {
    const int seg = item % NSEG, dir = (item / NSEG) & 1, bh = item / (2 * NSEG);
    f32x4 accS[8][2];
#pragma unroll
    for (int dt = 0; dt < 8; ++dt) { accS[dt][0] = (f32x4){0.f, 0.f, 0.f, 0.f}; accS[dt][1] = accS[dt][0]; }
    float dprod = 1.f;
    gla_walk<0>(P, lds, lj, bh >> 2, bh & 3, dir, seg, accS, dprod);
    float* sp = state + ((size_t)(bh * 2 + dir) * NSEG + seg) * 32768 + wid * 4096 + lane;
#pragma unroll
    for (int dt = 0; dt < 8; ++dt)
#pragma unroll
      for (int et2 = 0; et2 < 2; ++et2)
#pragma unroll
        for (int r = 0; r < 4; ++r) sp[((dt * 2 + et2) * 4 + r) * 64] = accS[dt][et2][r];
    if (tid < 128) dseg[((size_t)(bh * 2 + dir) * NSEG + seg) * 128 + tid] = dprod;
  }
}
DI void gla_scan_phase(const Params& P) {
  float* state = (float*)(P.ws + OFF_STATE);
  const float* dseg = (const float*)(P.ws + OFF_DSEG);
  const int gtid = blockIdx.x * 512 + otid(), gn = gridDim.x * 512;
  for (int i = gtid; i < 16 * 32768; i += gn) {
    const int e = i & 32767, bd = i >> 15, dir = bd & 1;
    const int reg = (e >> 6) & 63, d = (reg >> 3) * 16 + 4 * ((e & 63) >> 4) + (reg & 3);
    float loc[NSEG], dc[NSEG];
#pragma unroll
    for (int s2 = 0; s2 < NSEG; ++s2) {
      const int seg = dir ? (NSEG - 1 - s2) : s2;
      loc[s2] = state[((size_t)bd * NSEG + seg) * 32768 + e];
      dc[s2] = dseg[((size_t)bd * NSEG + seg) * 128 + d];
    }
    float run = 0.f;
#pragma unroll
    for (int s2 = 0; s2 < NSEG; ++s2) {
      const int seg = dir ? (NSEG - 1 - s2) : s2;
      state[((size_t)bd * NSEG + seg) * 32768 + e] = run;
      run = dc[s2] * run + loc[s2];
    }
  }
}
DI void gla_load_state(const float* sp, LAS unsigned char* lds, f32x4 (&accS)[8][2], int wid, int fr, int fq) {
#pragma unroll
  for (int dt = 0; dt < 8; ++dt)
#pragma unroll
    for (int et2 = 0; et2 < 2; ++et2) {
#pragma unroll
      for (int r = 0; r < 4; ++r) accS[dt][et2][r] = sp[((dt * 2 + et2) * 4 + r) * 64];
      u32x2 w; w.x = cvt_pk(accS[dt][et2][0], accS[dt][et2][1]); w.y = cvt_pk(accS[dt][et2][2], accS[dt][et2][3]);
      *(LAS u32x2*)(lds + GL_ST + ((2 * wid + et2) * 16 + fr) * GL_STS + (dt * 16 + 4 * fq) * 2) = w;
    }
}
DI void gla_out_phase(const Params& P, LAS unsigned char* lds, int lj) {
  const float* state = (const float*)(P.ws + OFF_STATE);
  __syncthreads();
  for (int item = blockIdx.x; item < 8 * NSEG; item += gridDim.x) {
    const int seg = item % NSEG, bh = item / NSEG;
    {
      const int tid = otid(), wid = tid >> 6, lane = tid & 63, fr = lane & 15, fq = lane >> 4;
      f32x4 accS[8][2]; float dprod = 1.f;
      gla_load_state(state + ((size_t)(bh * 2 + 0) * NSEG + seg) * 32768 + wid * 4096 + lane, lds, accS, wid, fr, fq);
      gla_walk<1>(P, lds, lj, bh >> 2, bh & 3, 0, seg, accS, dprod);
    }
    asm volatile("s_waitcnt vmcnt(0)" ::: "memory");
    __syncthreads();
    asm volatile("buffer_inv sc1" ::: "memory");
    {
      const int tid = otid(), wid = tid >> 6, lane = tid & 63, fr = lane & 15, fq = lane >> 4;
      f32x4 accS[8][2]; float dprod = 1.f;
      gla_load_state(state + ((size_t)(bh * 2 + 1) * NSEG + seg) * 32768 + wid * 4096 + lane, lds, accS, wid, fr, fq);
      gla_walk<2>(P, lds, lj, bh >> 2, bh & 3, 1, seg, accS, dprod);
    }
    __syncthreads();
  }
}


#define XB_TMO      128
#define XB_XCNT(j)  (256  + 64 * (j))
#define XB_XSUB(j)  (1280 + 64 * (j))
#define XB_XGEN(j)  (2304 + 64 * (j))
#define XB_TOP      3328
#define XB_TOPGEN   3392
#define XCD_BAR_WORDS 3456
#define XB_SPIN_CAP (1u << 20)
DI unsigned xb_ld(unsigned* p)              { return __hip_atomic_load(p, __ATOMIC_RELAXED, __HIP_MEMORY_SCOPE_AGENT); }
DI unsigned xb_add(unsigned* p, unsigned v) { return __hip_atomic_fetch_add(p, v, __ATOMIC_RELAXED, __HIP_MEMORY_SCOPE_AGENT); }
DI unsigned xb_xcc_id() { return (unsigned)__builtin_amdgcn_s_getreg((3 << 11) | 20) & 0xFu; }
#define XB_SPIN(cond, bar) do { unsigned _sp = 0; while (cond) { __builtin_amdgcn_s_sleep(1); \
    if ((++_sp & 255u) == 0u) { if (xb_ld(&(bar)[XB_TMO])) break; if (_sp > XB_SPIN_CAP) { atomicAdd(&(bar)[XB_TMO], 1u); break; } } } } while (0)
struct XcdBarrier { unsigned* bar; unsigned x; volatile LAS unsigned* st; };
DI XcdBarrier xcd_barrier_post(unsigned* bar, volatile LAS unsigned* st) {
  XcdBarrier b; b.bar = bar; b.x = xb_xcc_id(); b.st = st;
  if (threadIdx.x == 0) (void)xb_add(&bar[XB_XCNT(b.x)], 1u);
  return b;
}
DI void xcd_barrier_complete(unsigned* bar, unsigned x, unsigned& nloc, unsigned& nx) {
  const unsigned G = gridDim.x * gridDim.y * gridDim.z;
  unsigned sum, cnt, mine, sp = 0u;
  for (;;) {
    sum = 0u; cnt = 0u; mine = 0u;
#pragma unroll
    for (unsigned j = 0; j < 16; ++j) { const unsigned c = xb_ld(&bar[XB_XCNT(j)]); sum += c; cnt += (c > 0u) ? 1u : 0u; mine = (j == x) ? c : mine; }
    if (sum == G) break;
    __builtin_amdgcn_s_sleep(1);
    if ((++sp & 255u) == 0u) { if (xb_ld(&bar[XB_TMO])) break; if (sp > XB_SPIN_CAP) { atomicAdd(&bar[XB_TMO], 1u); break; } }
  }
  nloc = mine > 0u ? mine : 1u; nx = cnt > 0u ? cnt : 1u;
}
DI void xcd_barrier(const XcdBarrier& b) {
  asm volatile("s_waitcnt vmcnt(0)" ::: "memory");
  __syncthreads();
  if (threadIdx.x == 0) {
    unsigned* bar = b.bar;
    __builtin_amdgcn_s_waitcnt(0);
    unsigned nloc = b.st[0], nx = b.st[1];
    if (nloc == 0u) { xcd_barrier_complete(bar, b.x, nloc, nx); b.st[0] = nloc; b.st[1] = nx; }
    const unsigned old = xb_add(&bar[XB_XSUB(b.x)], 1u);
    const unsigned gen = old / nloc;
    if (old + 1u == (gen + 1u) * nloc) {
      __builtin_amdgcn_fence(__ATOMIC_RELEASE, "agent");
      asm volatile("s_waitcnt vmcnt(0)" ::: "memory");
      const unsigned og = xb_add(&bar[XB_TOP], 1u);
      const unsigned tg = og / nx;
      if (og + 1u == (tg + 1u) * nx) xb_add(&bar[XB_TOPGEN], 1u);
      else XB_SPIN(xb_ld(&bar[XB_TOPGEN]) == tg, bar);
      __builtin_amdgcn_fence(__ATOMIC_ACQUIRE, "agent");
      xb_add(&bar[XB_XGEN(b.x)], 1u);
      asm volatile("s_waitcnt vmcnt(0)" ::: "memory");
    } else {
      XB_SPIN(xb_ld(&bar[XB_XGEN(b.x)]) == gen, bar);
      __builtin_amdgcn_fence(__ATOMIC_ACQUIRE, "agent");
      asm volatile("s_waitcnt vmcnt(0)" ::: "memory");
    }
  }
  __syncthreads();
}

#ifndef PM
#define PM 0xFFFF
#endif
DI void run_phase(const Params& P, LAS unsigned char* lds, int ph) {
  unsigned char* ws = P.ws;
  bf16_t* hb = (bf16_t*)(ws + OFF_HB);
  if (ph == 0) { if (PM & 1) prep_phase(P, lds); return; }
  int li, sub;
  if (ph < 8) { li = 0; sub = ph - 1; } else if (ph < 16) { li = 1; sub = ph - 8; } else if (ph < 23) { li = 2; sub = ph - 16; } else { li = 3; sub = ph - 23; }
  const int lj = li >> 1;
  const bool isB = (li & 1) != 0;
  const int kind = isB ? (sub < 5 ? 0 : sub - 4) : (sub < 4 ? 0 : sub - 3);
  const bf16_t* W = (const bf16_t*)(ws + OFF_W0 + (size_t)(li & 1) * W_BYTES);
  if (kind == 2) { if (!(PM & 2)) return;
    EpiSwiglu e{(bf16_t*)(ws + OFF_ACT), (const float*)(ws + OFF_SS + SS_BYTES)};
    gemm_phase(lds, hb, W + W_GU, T_TOK, 2 * FFN_H, DM, e);
  } else if (kind == 3) { if (!(PM & 4)) return;
    EpiRes e{P.out, P.out, hb, (li < 3) ? (float*)(ws + OFF_SS) : nullptr};
    gemm_phase(lds, (const bf16_t*)(ws + OFF_ACT), W + W_DN, T_TOK, DM, FFN_H, e);
  } else if (kind == 1) { if (!(PM & 4)) return;
    EpiRes e{(li == 0) ? P.in[0] : P.out, P.out, hb, (float*)(ws + OFF_SS + SS_BYTES)};
    const bf16_t* Ain = isB ? (const bf16_t*)(ws + OFF_GATED) : (const bf16_t*)(ws + OFF_AOUT);
    gemm_phase(lds, Ain, W + W_OUT, T_TOK, DM, DM, e);
    if (li < 3) convert_layer(P, lds, li + 1);
  } else if (!isB) {
    const int b = sub >> 1;
    if ((sub & 1) == 0) { if (!(PM & 8)) return;
      EpiQKV e{(bf16_t*)(ws + OFF_QKV), (const float*)(ws + OFF_SS) + (size_t)b * S_LEN * 4, P.in[4] + lj * 192, P.in[5] + lj * 192,
               (const float*)(ws + OFF_COS), (const float*)(ws + OFF_SIN)};
      gemm_phase(lds, hb + (size_t)b * S_LEN * DM, W + W_IN, S_LEN, 9216, DM, e);
    } else if (PM & 16) attn_phase(P, lds, b);
  } else {
    if (sub == 0) { if (!(PM & 32)) return;
      EpiProj e{(bf16_t*)(ws + OFF_PROJ), (float*)(ws + OFF_Z), (const float*)(ws + OFF_SS)};
      gemm_phase(lds, hb, W + W_IN, T_TOK, 3328, DM, e);
    } else if (sub == 1) { if (PM & 512) gla_gate_phase(P, lds, lj); }
    else if (sub == 2) { if (PM & 64) gla_sum_phase(P, lds, lj); }
    else if (sub == 3) { if (PM & 128) gla_scan_phase(P); }
    else if (PM & 256) gla_out_phase(P, lds, lj);
  }
}

__global__ void __launch_bounds__(512, 2) mega_fwd(Params P) {
  extern __shared__ __attribute__((aligned(16))) unsigned char lds_raw[];
  LAS unsigned char* lds = (LAS unsigned char*)lds_raw;
  cg::grid_group grid = cg::this_grid();
  volatile LAS unsigned* xst = (volatile LAS unsigned*)(lds + LDS_BYTES - 16);
  if (threadIdx.x == 0) { xst[0] = 0u; xst[1] = 0u; }
  __syncthreads();
  const XcdBarrier xb = xcd_barrier_post((unsigned*)(P.ws + OFF_BAR), xst);
  for (int ph = P.ph_lo; ph < P.ph_hi; ++ph) {
    if (ph > P.ph_lo) { if (ph == P.ph_lo + 1) grid.sync(); else xcd_barrier(xb); }
    run_phase(P, lds, ph);
  }
}

extern "C" void kernel_launch(void* const* d_in, const int* in_sizes, int n_in, void* d_out, int out_size, void* d_ws, size_t ws_size,
                              hipStream_t stream) {
  static int grid = 0;
  if (grid == 0) {
    int dev = 0, cus = 0, per_cu = 0;
    hipGetDevice(&dev);
    hipDeviceGetAttribute(&cus, hipDeviceAttributeMultiprocessorCount, dev);
    if (hipFuncSetAttribute((const void*)mega_fwd, hipFuncAttributeMaxDynamicSharedMemorySize, LDS_BYTES) != hipSuccess)
      fprintf(stderr, "kernel_launch: hipFuncSetAttribute failed\n");
    if (hipOccupancyMaxActiveBlocksPerMultiprocessor(&per_cu, (const void*)mega_fwd, 512, LDS_BYTES) != hipSuccess || per_cu < 1) {
      fprintf(stderr, "kernel_launch: occupancy query says %d\n", per_cu); per_cu = 1; (void)hipGetLastError();
    }
    grid = cus * per_cu;
    if (ws_size < WS_NEED) fprintf(stderr, "kernel_launch: workspace too small: %zu < %zu\n", ws_size, (size_t)WS_NEED);
  }
  Params p{};
  for (int i = 0; i < 16; ++i) p.in[i] = (const float*)d_in[i];
  p.out = (float*)d_out; p.ws = (unsigned char*)d_ws; p.ph_lo = 0; p.ph_hi = NPHASES;
  (void)hipMemsetAsync((unsigned char*)d_ws + OFF_BAR, 0, XCD_BAR_WORDS * sizeof(unsigned), stream);
  void* args[] = {&p};
  hipError_t e = hipLaunchCooperativeKernel((const void*)mega_fwd, dim3(grid), dim3(512), args, LDS_BYTES, stream);
  if (e != hipSuccess) fprintf(stderr, "kernel_launch: cooperative launch failed: %s (grid %d)\n", hipGetErrorString(e), grid);
}
```

```cpp
#include <hip/hip_runtime.h>
#include <hip/hip_cooperative_groups.h>
#include <cstdio>
#include <cstdint>
namespace cg = cooperative_groups;

#define DI __device__ __forceinline__
#define LAS __attribute__((address_space(3)))
typedef unsigned short bf16_t;
typedef short bf16x8 __attribute__((ext_vector_type(8)));
typedef short s16x4 __attribute__((ext_vector_type(4)));
typedef float f32x4 __attribute__((ext_vector_type(4)));
typedef unsigned u32x4 __attribute__((ext_vector_type(4)));
typedef unsigned u32x2 __attribute__((ext_vector_type(2)));

constexpr int T_TOK = 32768, S_LEN = 16384, DM = 1024, FFN_H = 2816;
constexpr float EPS = 1e-6f;
constexpr float LOG2E = 1.4426950408889634f;
constexpr int NPHASES = 31;
constexpr int LDS_BYTES = 155648;
constexpr int NSEG = 32, CPS = 8;

constexpr size_t MiB = 1048576;
constexpr size_t OFF_SS = 0, SS_BYTES = 2 * MiB, OFF_COS = 4 * MiB, OFF_SIN = 6 * MiB, OFF_LSE = 8 * MiB, OFF_Z = 9 * MiB, OFF_DSEG = 13 * MiB, OFF_DEC = 14 * MiB;
constexpr size_t OFF_W0 = 16 * MiB, W_BYTES = 37 * MiB, OFF_HB = 90 * MiB, OFF_R = 154 * MiB;
constexpr size_t OFF_QKV = OFF_R, OFF_AOUT = OFF_R + 288 * MiB;
constexpr size_t OFF_PROJ = OFF_R, OFF_GATED = OFF_R + 192 * MiB, OFF_STATE = OFF_R + 256 * MiB;
constexpr size_t OFF_ACT = OFF_R;
constexpr size_t WS_NEED = 506 * MiB;
constexpr size_t OFF_BAR = OFF_DSEG + 512 * 1024;
constexpr size_t W_IN = 0, W_OUT = 9437184, W_GU = 10485760, W_DN = 16252928;

struct Params {
  const float* in[16];
  float* out;
  unsigned char* ws;
  int ph_lo, ph_hi;
};

DI float bf2f(bf16_t v) { return __uint_as_float(((unsigned)v) << 16); }
DI unsigned cvt_pk(float lo, float hi) { unsigned r; asm("v_cvt_pk_bf16_f32 %0, %1, %2" : "=v"(r) : "v"(lo), "v"(hi)); return r; }
DI bf16_t f2bf(float f) { return (bf16_t)(cvt_pk(f, 0.f) & 0xffffu); }
DI float fast_exp2(float x) { return __builtin_amdgcn_exp2f(x); }
DI float fast_log2(float x) { return __builtin_amdgcn_logf(x); }
DI float fast_rcp(float x) { return __builtin_amdgcn_rcpf(x); }
DI float fast_exp(float x) { return __builtin_amdgcn_exp2f(x * LOG2E); }
DI int otid() { int t = threadIdx.x; asm volatile("" : "+v"(t)); return t; }
DI float row_rstd(const float* ssp, size_t row) {
  const f32x4 a = *(const f32x4*)(ssp + row * 16), b = *(const f32x4*)(ssp + row * 16 + 4), c = *(const f32x4*)(ssp + row * 16 + 8), d = *(const f32x4*)(ssp + row * 16 + 12);
  const float s = (((a[0] + a[1]) + (a[2] + a[3])) + ((b[0] + b[1]) + (b[2] + b[3]))) + (((c[0] + c[1]) + (c[2] + c[3])) + ((d[0] + d[1]) + (d[2] + d[3])));
  return rsqrtf(s * (1.0f / 1024.0f) + 1e-6f);
}
DI int perm32(int p) { return 8 * ((p & 15) >> 2) + 4 * (p >> 4) + (p & 3); }
DI f32x4 mfma16(bf16x8 a, bf16x8 b, f32x4 c) { return __builtin_amdgcn_mfma_f32_16x16x32_bf16(a, b, c, 0, 0, 0); }
DI bf16x8 tr_pair(LAS unsigned char* p0, LAS unsigned char* p1) {
  s16x4 a = __builtin_amdgcn_ds_read_tr16_b64_v4i16((LAS s16x4*)p0);
  s16x4 b = __builtin_amdgcn_ds_read_tr16_b64_v4i16((LAS s16x4*)p1);
  bf16x8 f; f[0] = a[0]; f[1] = a[1]; f[2] = a[2]; f[3] = a[3]; f[4] = b[0]; f[5] = b[1]; f[6] = b[2]; f[7] = b[3];
  return f;
}

constexpr int BM = 256, BK = 64, HALF = 128;
DI int lds_byte(int r, int c) { int st = (r >> 4) * 2 + (c >> 5), rr = r & 15, cc = c & 31, ob = rr * 64 + cc * 2; return st * 1024 + (ob ^ (((ob >> 9) & 1) << 5)); }
DI void stage_rc(int b, int& R, int& C) { int st = b / 1024, sb = b % 1024, swz = sb ^ (((sb >> 9) & 1) << 5); R = (st >> 1) * 16 + swz / 64; C = (st & 1) * 32 + (swz % 64) / 2; }

#define G_SA(b, h) (((b) * 2 + (h)) * 16384)
#define G_SB(b, h) ((4 + (b) * 2 + (h)) * 16384)
#define G_STAGE(PO, BASE, br, kt) do { const bf16_t* _g = (BASE) + (long)(br) * K + (long)(kt) * BK; \
    _Pragma("unroll") for (int _i = 0; _i < 2; ++_i) \
      __builtin_amdgcn_global_load_lds((const unsigned*)(_g + soff[_i]), (LAS unsigned*)(lds + (PO) + tid * 16 + _i * 8192), 16, 0, 0); } while (0)
#define G_LDA(dst, b, h) do { _Pragma("unroll") for (int m = 0; m < 4; ++m) _Pragma("unroll") for (int k = 0; k < 2; ++k) \
    dst[m][k] = *(const LAS bf16x8*)(lds + G_SA(b, h) + aoff + m * 2048 + k * 1024); } while (0)
#define G_LDB(dst, b, h) do { _Pragma("unroll") for (int n = 0; n < 2; ++n) _Pragma("unroll") for (int k = 0; k < 2; ++k) \
    dst[n][k] = *(const LAS bf16x8*)(lds + G_SB(b, h) + boff + n * 2048 + k * 1024); } while (0)
#define G_MMA(ai, bj, At_, Bt_) do { __builtin_amdgcn_s_setprio(1); \
    _Pragma("unroll") for (int m = 0; m < 4; ++m) _Pragma("unroll") for (int n = 0; n < 2; ++n) _Pragma("unroll") for (int k = 0; k < 2; ++k) \
      acc[ai][bj][m][n] = __builtin_amdgcn_mfma_f32_16x16x32_bf16(Bt_[n][k], At_[m][k], acc[ai][bj][m][n], 0, 0, 0); \
    __builtin_amdgcn_s_setprio(0); } while (0)
#define WAIT_V(n) asm volatile("s_waitcnt vmcnt(" #n ")" ::: "memory")
#define WAIT_L(n) asm volatile("s_waitcnt lgkmcnt(" #n ")" ::: "memory")
#define BAR __builtin_amdgcn_s_barrier()
#define SCHED __builtin_amdgcn_sched_barrier(0)
#define LBAR_ do { asm volatile("s_waitcnt lgkmcnt(0)" ::: "memory"); __builtin_amdgcn_s_barrier(); asm volatile("" ::: "memory"); } while (0)

DI float rstd_of(const f32x4 s) { return rsqrtf(((s[0] + s[1]) + (s[2] + s[3])) * (1.0f / 1024.0f) + 1e-6f); }
template <class Epi>
DI void gemm_tile(LAS unsigned char* lds, const bf16_t* __restrict__ A, const bf16_t* __restrict__ Bt, const int K,
                  const int pm, const int pn, const Epi& epi, const bool first, const bool have_next, const int npm, const int npn) {
  const int tid = otid();
  const int wid = tid >> 6, lane = tid & 63, wr = wid >> 2, wc = wid & 3, fr = lane & 15, fq = lane >> 4;
  const int brow = pm * BM, bcol = pn * BM;
  long soff[2];
  { int r_, c_; stage_rc(tid * 16, r_, c_); soff[0] = (long)r_ * K + c_; stage_rc(tid * 16 + 8192, r_, c_); soff[1] = (long)r_ * K + c_; }
  const int aoff = lds_byte(wr * 64 + fr, fq * 8), boff = lds_byte(wc * 32 + fr, fq * 8);
  f32x4 acc[2][2][4][2];
#pragma unroll
  for (int a = 0; a < 2; ++a)
#pragma unroll
    for (int b = 0; b < 2; ++b)
#pragma unroll
      for (int m = 0; m < 4; ++m)
#pragma unroll
        for (int n = 0; n < 2; ++n) acc[a][b][m][n] = (f32x4){0.f, 0.f, 0.f, 0.f};
  bf16x8 At[4][2], B0[2][2], B1[2][2];
  const int nt = K / BK;
  if (first) {
    __syncthreads();
    G_STAGE(G_SB(0, 0), Bt, bcol, 0); G_STAGE(G_SA(0, 0), A, brow, 0);
    G_STAGE(G_SB(0, 1), Bt, bcol + HALF, 0); G_STAGE(G_SA(0, 1), A, brow + HALF, 0);
  }
  f32x4 svr = (f32x4){0.f, 0.f, 0.f, 0.f};
  if constexpr (Epi::RSTD) svr = *(const f32x4*)(epi.ss + (size_t)(brow + (tid & 255)) * 4);
  f32x4 pr0 = svr, pr1 = svr; float prg = 0.f;
  if constexpr (Epi::ROPE) epi.pre_load(pr0, pr1, prg, brow, pn, tid);
  if (wr == 1) BAR;
  WAIT_V(0); BAR;
  if constexpr (Epi::RSTD) ((LAS float*)(lds + 135168))[tid & 255] = rstd_of(svr);
  if constexpr (Epi::ROPE) epi.pre_store(lds, pr0, pr1, prg, tid);
  G_STAGE(G_SB(1, 0), Bt, bcol, 1); G_STAGE(G_SA(1, 0), A, brow, 1); G_STAGE(G_SB(1, 1), Bt, bcol + HALF, 1);
  WAIT_V(6); BAR;
  for (int t = 0; t < nt - 2; t += 2) {
    G_LDB(B0, 0, 0); SCHED; G_LDA(At, 0, 0); G_STAGE(G_SA(1, 1), A, brow + HALF, t + 1);
    WAIT_L(8); BAR; WAIT_L(0); G_MMA(0, 0, At, B0); BAR; SCHED;
    G_LDB(B1, 0, 1); G_STAGE(G_SB(0, 0), Bt, bcol, t + 2);
    BAR; WAIT_L(0); G_MMA(0, 1, At, B1); BAR;
    G_LDA(At, 0, 1); G_STAGE(G_SA(0, 0), A, brow, t + 2);
    BAR; WAIT_L(0); G_MMA(1, 0, At, B0); BAR; SCHED;
    G_STAGE(G_SB(0, 1), Bt, bcol + HALF, t + 2);
    WAIT_V(6); BAR; G_MMA(1, 1, At, B1); BAR;
    G_LDB(B0, 1, 0); SCHED; G_LDA(At, 1, 0); G_STAGE(G_SA(0, 1), A, brow + HALF, t + 2);
    WAIT_L(8); BAR; WAIT_L(0); G_MMA(0, 0, At, B0); BAR; SCHED;
    G_LDB(B1, 1, 1); G_STAGE(G_SB(1, 0), Bt, bcol, t + 3);
    BAR; WAIT_L(0); G_MMA(0, 1, At, B1); BAR;
    G_LDA(At, 1, 1); G_STAGE(G_SA(1, 0), A, brow, t + 3);
    BAR; WAIT_L(0); G_MMA(1, 0, At, B0); BAR; SCHED;
    G_STAGE(G_SB(1, 1), Bt, bcol + HALF, t + 3);
    WAIT_V(6); BAR; G_MMA(1, 1, At, B1); BAR;
  }
  { G_LDB(B0, 0, 0); G_LDA(At, 0, 0); G_STAGE(G_SA(1, 1), A, brow + HALF, nt - 1);
    BAR; WAIT_L(0); G_MMA(0, 0, At, B0); BAR;
    G_LDB(B1, 0, 1); BAR; WAIT_L(0); G_MMA(0, 1, At, B1); BAR;
    G_LDA(At, 0, 1); WAIT_V(4); BAR; WAIT_L(0); G_MMA(1, 0, At, B0); G_MMA(1, 1, At, B1); BAR; }
  { G_LDB(B0, 1, 0); G_LDA(At, 1, 0); WAIT_V(2); BAR;
    if (have_next) {
      const int nbrow = npm * BM, nbcol = npn * BM;
      G_STAGE(G_SB(0, 0), Bt, nbcol, 0); G_STAGE(G_SA(0, 0), A, nbrow, 0);
      G_STAGE(G_SB(0, 1), Bt, nbcol + HALF, 0); G_STAGE(G_SA(0, 1), A, nbrow + HALF, 0);
    }
    WAIT_L(0); G_MMA(0, 0, At, B0); BAR;
    G_LDB(B1, 1, 1); if (have_next) { WAIT_V(8); } else { WAIT_V(0); } BAR; WAIT_L(0); G_MMA(0, 1, At, B1); BAR;
    G_LDA(At, 1, 1); BAR; WAIT_L(0); G_MMA(1, 0, At, B0); G_MMA(1, 1, At, B1); BAR; }
  if (wr == 0) BAR;
  epi(lds, acc, pm, pn, wr, wc, fr, fq);
}

DI bool gemm_unit(int i, int nM, int nN, int& pm, int& pn) {
  const int nwg = nM * nN;
  const long L = (long)i * gridDim.x + blockIdx.x;
  if (L >= nwg) return false;
  int wgid = (int)L;
  { const int q = nwg / 8, r = nwg % 8, xcd = wgid % 8, off = wgid / 8; wgid = (xcd < r ? xcd * (q + 1) : r * (q + 1) + (xcd - r) * q) + off; }
  const int nig = 8 * nN, gid = wgid / nig, fm = gid * 8, gsz = (nM - fm) < 8 ? (nM - fm) : 8;
  pm = fm + ((wgid % nig) % gsz); pn = (wgid % nig) / gsz;
  return true;
}
template <class Epi>
DI void gemm_phase(LAS unsigned char* lds, const bf16_t* A, const bf16_t* Bt, int M, int N, int K, const Epi& epi) {
  const int nM = M / BM, nN = N / BM;
  int pm, pn;
  if (!gemm_unit(0, nM, nN, pm, pn)) return;
  for (int i = 0;; ++i) {
    int npm = 0, npn = 0;
    const bool have_next = gemm_unit(i + 1, nM, nN, npm, npn);
    gemm_tile(lds, A, Bt, K, pm, pn, epi, i == 0, have_next, npm, npn);
    if (!have_next) break;
    pm = npm; pn = npn;
  }
}

#define EPI_FENCE asm volatile("" ::: "memory")
constexpr int EQ_GN = 136192, EQ_CS = 136448, EQ_CSS = 272;
struct EpiQKV {
  static constexpr bool RSTD = true, ROPE = true;
  bf16_t* qkv; const float* ss; const float* qg; const float* kg; const float* cosT; const float* sinT;
  DI void pre_load(f32x4& r0, f32x4& r1, float& g, int brow, int pn, int tid) const {
    const int type = (pn % 12) >> 2, gi = pn / 12;
    const int c = 2 * tid, tr = c >> 4, q = c & 15;
    const size_t s = (size_t)(brow + (tr >> 5) * 64 + (tr & 31));
    const float* src = (q < 8) ? (cosT + s * 32 + 4 * q) : (sinT + s * 32 + 4 * (q - 8));
    r0 = *(const f32x4*)src; r1 = *(const f32x4*)(src + 4);
    g = ((type == 0) ? qg : kg)[gi * 64 + (tid & 63)];
  }
  DI void pre_store(LAS unsigned char* lds, const f32x4& r0, const f32x4& r1, float g, int tid) const {
    const int c = 2 * tid, tr = c >> 4, q = c & 15;
    *(LAS f32x4*)(lds + EQ_CS + tr * EQ_CSS + q * 16) = r0;
    *(LAS f32x4*)(lds + EQ_CS + tr * EQ_CSS + q * 16 + 16) = r1;
    if (tid < 64) ((LAS float*)(lds + EQ_GN))[tid] = g;
  }
  DI void operator()(LAS unsigned char* lds, f32x4 (&acc)[2][2][4][2], int pm, int pn, int wr, int wc, int fr, int fq) const {
    const int g = pn / 12, type = (pn % 12) >> 2, head = (pn & 3) * 4 + wc;
    bf16_t* base = qkv + (size_t)((g * 3 + type) * 16 + head) * S_LEN * 64;
    const float* gp = (type == 0 ? qg : kg) + g * 64;
    const int s0 = pm * BM + wr * 64 + fr;
    float rstd[2][4];
#pragma unroll
    for (int ai = 0; ai < 2; ++ai)
#pragma unroll
      for (int m = 0; m < 4; ++m) rstd[ai][m] = ((const LAS float*)(lds + 135168))[ai * HALF + wr * 64 + m * 16 + fr];
    f32x4 g1[2], g2[2];
    if (type < 2) {
#pragma unroll
      for (int n = 0; n < 2; ++n) { g1[n] = *(const LAS f32x4*)(lds + EQ_GN + (8 * fq + 4 * n) * 4); g2[n] = *(const LAS f32x4*)(lds + EQ_GN + (32 + 8 * fq + 4 * n) * 4); }
    }
#pragma unroll
    for (int aim = 0; aim < 4; ++aim) {
      const int ai = aim >> 1, mb = (aim & 1) * 2;
      f32x4 cs[4][2], sn[4][2];
      if (type < 2) {
#pragma unroll
        for (int m = mb; m < mb + 2; ++m)
#pragma unroll
          for (int n = 0; n < 2; ++n) {
            if (aim == 0) {
              const int tr = wr * 32 + m * 16 + fr;
              cs[m][n] = *(const LAS f32x4*)(lds + EQ_CS + tr * EQ_CSS + (8 * fq + 4 * n) * 4);
              sn[m][n] = *(const LAS f32x4*)(lds + EQ_CS + tr * EQ_CSS + 128 + (8 * fq + 4 * n) * 4);
            } else {
              const size_t o = (size_t)(s0 + ai * HALF + m * 16) * 32 + 8 * fq + 4 * n;
              cs[m][n] = *(const f32x4*)(cosT + o); sn[m][n] = *(const f32x4*)(sinT + o);
            }
          }
      }
      EPI_FENCE;
#pragma unroll
      for (int m = mb; m < mb + 2; ++m) {
        const int s = s0 + ai * HALF + m * 16;
        f32x4 v[2][2];
#pragma unroll
        for (int bj = 0; bj < 2; ++bj)
#pragma unroll
          for (int n = 0; n < 2; ++n) v[bj][n] = acc[ai][bj][m][n] * rstd[ai][m];
        if (type < 2) {
          float q = 0.f;
#pragma unroll
          for (int bj = 0; bj < 2; ++bj)
#pragma unroll
            for (int n = 0; n < 2; ++n) q += v[bj][n][0] * v[bj][n][0] + v[bj][n][1] * v[bj][n][1] + v[bj][n][2] * v[bj][n][2] + v[bj][n][3] * v[bj][n][3];
          q += __shfl_xor(q, 16); q += __shfl_xor(q, 32);
          float rn = rsqrtf(q * (1.0f / 64.0f) + EPS);
          if (type == 0) rn *= 0.125f * LOG2E;
#pragma unroll
          for (int n = 0; n < 2; ++n) {
            const f32x4 x1 = v[0][n] * g1[n] * rn, x2 = v[1][n] * g2[n] * rn;
            v[0][n] = x1 * cs[m][n] - x2 * sn[m][n]; v[1][n] = x2 * cs[m][n] + x1 * sn[m][n];
          }
        }
        bf16_t* rp = base + (size_t)s * 64 + 8 * fq;
#pragma unroll
        for (int bj = 0; bj < 2; ++bj) {
          u32x4 w; w.x = cvt_pk(v[bj][0][0], v[bj][0][1]); w.y = cvt_pk(v[bj][0][2], v[bj][0][3]); w.z = cvt_pk(v[bj][1][0], v[bj][1][1]); w.w = cvt_pk(v[bj][1][2], v[bj][1][3]);
          *(u32x4*)(rp + bj * 32) = w;
        }
      }
      EPI_FENCE;
    }
  }
};
struct EpiRes {
  static constexpr bool RSTD = false, ROPE = false;
  const float* resid; float* hout; bf16_t* hb; float* ssn;
  DI void operator()(LAS unsigned char* lds, f32x4 (&acc)[2][2][4][2], int pm, int pn, int wr, int wc, int fr, int fq) const {
    const size_t base0 = (size_t)(pm * BM + wr * 64 + fr) * DM + pn * BM + wc * 32 + fq * 4;
    LAS float* red = (LAS float*)(lds + 131072);
#pragma unroll
    for (int ai = 0; ai < 2; ++ai) {
      f32x4 rv[4][2][2];
#pragma unroll
      for (int m = 0; m < 4; ++m)
#pragma unroll
        for (int bj = 0; bj < 2; ++bj)
#pragma unroll
          for (int n = 0; n < 2; ++n) rv[m][bj][n] = *(const f32x4*)(resid + base0 + (size_t)(ai * HALF + m * 16) * DM + bj * HALF + n * 16);
      EPI_FENCE;
#pragma unroll
      for (int m = 0; m < 4; ++m) {
        const size_t off0 = base0 + (size_t)(ai * HALF + m * 16) * DM;
        float* op = hout + off0; bf16_t* bp = hb + off0;
        float q = 0.f;
#pragma unroll
        for (int bj = 0; bj < 2; ++bj)
#pragma unroll
          for (int n = 0; n < 2; ++n) {
            const f32x4 o = rv[m][bj][n] + acc[ai][bj][m][n];
            *(f32x4*)(op + bj * HALF + n * 16) = o;
            q += o[0] * o[0] + o[1] * o[1] + o[2] * o[2] + o[3] * o[3];
            u32x2 w; w.x = cvt_pk(o[0], o[1]); w.y = cvt_pk(o[2], o[3]);
            *(u32x2*)(bp + bj * HALF + n * 16) = w;
          }
        q += __shfl_xor(q, 16); q += __shfl_xor(q, 32);
        if (fq == 0) red[(ai * HALF + wr * 64 + m * 16 + fr) * 4 + wc] = q;
      }
      EPI_FENCE;
    }
    LBAR_;
    if (ssn) {
      const int t = threadIdx.x;
      if (t < 256) { const f32x4 p = *(const LAS f32x4*)(red + t * 4); ssn[(size_t)(pm * BM + t) * 4 + pn] = (p[0] + p[1]) + (p[2] + p[3]); }
    }
  }
};
struct EpiSwiglu {
  static constexpr bool RSTD = true, ROPE = false;
  bf16_t* act; const float* ss;
  DI void operator()(LAS unsigned char* lds, f32x4 (&acc)[2][2][4][2], int pm, int pn, int wr, int wc, int fr, int fq) const {
    const size_t r0 = (size_t)(pm * BM + wr * 64 + fr);
#pragma unroll
    for (int ai = 0; ai < 2; ++ai)
#pragma unroll
      for (int m = 0; m < 4; ++m) {
        const size_t row = r0 + ai * HALF + m * 16;
        const float rstd = ((const LAS float*)(lds + 135168))[ai * HALF + wr * 64 + m * 16 + fr];
        float o[8];
#pragma unroll
        for (int n = 0; n < 2; ++n)
#pragma unroll
          for (int j = 0; j < 4; ++j) {
            const float gg = acc[ai][0][m][n][j] * rstd, uu = acc[ai][1][m][n][j] * rstd;
            o[n * 4 + j] = gg * fast_rcp(1.0f + fast_exp(-gg)) * uu;
          }
        u32x4 w; w.x = cvt_pk(o[0], o[1]); w.y = cvt_pk(o[2], o[3]); w.z = cvt_pk(o[4], o[5]); w.w = cvt_pk(o[6], o[7]);
        *(u32x4*)(act + row * FFN_H + pn * 128 + wc * 32 + 8 * fq) = w;
      }
  }
};
struct EpiProj {
  static constexpr bool RSTD = true, ROPE = false;
  bf16_t* proj; float* zbuf; const float* ss;
  DI void operator()(LAS unsigned char* lds, f32x4 (&acc)[2][2][4][2], int pm, int pn, int wr, int wc, int fr, int fq) const {
    const size_t r0 = (size_t)(pm * BM + wr * 64 + fr);
#pragma unroll
    for (int ai = 0; ai < 2; ++ai)
#pragma unroll
      for (int m = 0; m < 4; ++m) {
        const size_t row = r0 + ai * HALF + m * 16;
        const float rstd = ((const LAS float*)(lds + 135168))[ai * HALF + wr * 64 + m * 16 + fr];
        if (pn < 12) {
#pragma unroll
          for (int bj = 0; bj < 2; ++bj) {
            const f32x4 a = acc[ai][bj][m][0] * rstd, b = acc[ai][bj][m][1] * rstd;
            u32x4 w; w.x = cvt_pk(a[0], a[1]); w.y = cvt_pk(a[2], a[3]); w.z = cvt_pk(b[0], b[1]); w.w = cvt_pk(b[2], b[3]);
            *(u32x4*)(proj + row * 3072 + pn * BM + bj * HALF + wc * 32 + 8 * fq) = w;
          }
        } else if (wc == 0) {
          *(f32x4*)(zbuf + row * 32 + 8 * fq) = acc[ai][0][m][0] * rstd;
          *(f32x4*)(zbuf + row * 32 + 8 * fq + 4) = acc[ai][0][m][1] * rstd;
        }
      }
  }
};

struct ConvJob { const float* src; bf16_t* dst; const float* gain; int K, Nsrc, Ndst, mode; };
DI void conv_tile(LAS unsigned char* lds, const ConvJob& J, int t) {
  LAS float* tile = (LAS float*)lds;
  const int tid = otid();
  const int nkt = J.K / 64, nt_ = t / nkt, kt = t % nkt;
  const int nn = tid & 255, np = nt_ * 256 + nn;
  int src; float cs = 1.f;
  if (J.mode == 0) src = np;
  else if (J.mode == 1) { const int r = np & 255; src = (np & ~255) + ((r >> 5) & 3) * 64 + (r >> 7) * 32 + perm32(r & 31); }
  else if (J.mode == 2) { const int r = np & 255; src = (r >> 7) * FFN_H + (np >> 8) * 128 + ((r >> 5) & 3) * 32 + perm32(r & 31); }
  else { src = (np & ~31) + perm32(np & 31); if (src < 512) cs = 0.08838834764831845f; if (src >= 3104) src = -1; }
  float v[32];
#pragma unroll
  for (int e = 0; e < 32; ++e) {
    const int k = kt * 64 + (tid >> 8) + 2 * e;
    v[e] = (src >= 0) ? J.src[(size_t)k * J.Nsrc + src] : 0.f;
  }
  if (J.gain) {
#pragma unroll
    for (int e = 0; e < 32; ++e) v[e] *= J.gain[kt * 64 + (tid >> 8) + 2 * e];
  }
  __syncthreads();
#pragma unroll
  for (int e = 0; e < 32; ++e) tile[((tid >> 8) + 2 * e) * 257 + nn] = v[e] * cs;
  __syncthreads();
#pragma unroll
  for (int p = 0; p < 4; ++p) {
    const int n2 = (tid >> 3) + 64 * p, kc = tid & 7;
    float f[8];
#pragma unroll
    for (int j = 0; j < 8; ++j) f[j] = tile[(kc * 8 + j) * 257 + n2];
    u32x4 w; w.x = cvt_pk(f[0], f[1]); w.y = cvt_pk(f[2], f[3]); w.z = cvt_pk(f[4], f[5]); w.w = cvt_pk(f[6], f[7]);
    *(u32x4*)(J.dst + (size_t)(nt_ * 256 + n2) * J.K + kt * 64 + kc * 8) = w;
  }
}
DI void convert_layer(const Params& P, LAS unsigned char* lds, int li) {
  bf16_t* W = (bf16_t*)(P.ws + OFF_W0 + (size_t)(li & 1) * W_BYTES);
  const int j = li >> 1;
  ConvJob J[4];
  if ((li & 1) == 0) {
    J[0] = ConvJob{P.in[3] + (size_t)j * DM * 9216, W + W_IN, P.in[1] + li * DM, DM, 9216, 9216, 1};
    J[1] = ConvJob{P.in[6] + (size_t)j * DM * DM, W + W_OUT, nullptr, DM, DM, DM, 0};
  } else {
    J[0] = ConvJob{P.in[7] + (size_t)j * DM * 3104, W + W_IN, P.in[1] + li * DM, DM, 3104, 3328, 3};
    J[1] = ConvJob{P.in[13] + (size_t)j * DM * DM, W + W_OUT, nullptr, DM, DM, DM, 0};
  }
  J[2] = ConvJob{P.in[14] + (size_t)li * DM * 2 * FFN_H, W + W_GU, P.in[2] + li * DM, DM, 2 * FFN_H, 2 * FFN_H, 2};
  J[3] = ConvJob{P.in[15] + (size_t)li * FFN_H * DM, W + W_DN, nullptr, FFN_H, DM, DM, 0};
  int cnt[4], tot = 0;
#pragma unroll
  for (int q = 0; q < 4; ++q) { cnt[q] = (J[q].Ndst / 256) * (J[q].K / 64); tot += cnt[q]; }
  for (int t = blockIdx.x; t < tot; t += gridDim.x) {
    int tt = t;
    if (tt < cnt[0]) { conv_tile(lds, J[0], tt); continue; } tt -= cnt[0];
    if (tt < cnt[1]) { conv_tile(lds, J[1], tt); continue; } tt -= cnt[1];
    if (tt < cnt[2]) { conv_tile(lds, J[2], tt); continue; } tt -= cnt[2];
    conv_tile(lds, J[3], tt);
  }
  __syncthreads();
}

DI void prep_phase(const Params& P, LAS unsigned char* lds) {
  const int tid = otid(), wid = tid >> 6, lane = tid & 63;
  const float* x = P.in[0];
  bf16_t* hb = (bf16_t*)(P.ws + OFF_HB);
  float* ss = (float*)(P.ws + OFF_SS);
  for (int row = blockIdx.x * 8 + wid; row < T_TOK; row += gridDim.x * 8) {
    const float* xr = x + (size_t)row * DM;
    float q = 0.f;
#pragma unroll
    for (int e = 0; e < 4; ++e) {
      const f32x4 v = *(const f32x4*)(xr + e * 256 + lane * 4);
      q += v[0] * v[0] + v[1] * v[1] + v[2] * v[2] + v[3] * v[3];
      u32x2 w; w.x = cvt_pk(v[0], v[1]); w.y = cvt_pk(v[2], v[3]);
      *(u32x2*)(hb + (size_t)row * DM + e * 256 + lane * 4) = w;
    }
#pragma unroll
    for (int o = 1; o < 64; o <<= 1) q += __shfl_xor(q, o);
    if (lane < 4) ss[(size_t)row * 4 + lane] = (lane == 0) ? q : 0.f;
  }
  const int gtid = blockIdx.x * 512 + tid, gn = gridDim.x * 512;
  float* cosT = (float*)(P.ws + OFF_COS); float* sinT = (float*)(P.ws + OFF_SIN);
  for (int i = gtid; i < S_LEN * 32; i += gn) {
    const int s = i >> 5, fi = i & 31;
    double f = 1.0;
    for (int k = 0; k < fi; ++k) f *= 0.7498942093324559;
    double rev = (double)s * f * 0.15915494309189535;
    rev -= __builtin_rint(rev);
    cosT[i] = __builtin_amdgcn_cosf((float)rev);
    sinT[i] = __builtin_amdgcn_sinf((float)rev);
  }
  convert_layer(P, lds, 0);
}

constexpr int AT_STR = 144, AT_VOFF = 416 * AT_STR;
#define LBAR do { asm volatile("s_waitcnt lgkmcnt(0)" ::: "memory"); __builtin_amdgcn_s_barrier(); asm volatile("" ::: "memory"); } while (0)
DI void attn_phase(const Params& P, LAS unsigned char* lds, int b) {
  const int tid = otid(), wid = tid >> 6, lane = tid & 63, fr = lane & 15, fq = lane >> 4;
  const bf16_t* qkv = (const bf16_t*)(P.ws + OFF_QKV);
  bf16_t* aout = (bf16_t*)(P.ws + OFF_AOUT) + (size_t)b * S_LEN * DM;
  float* lse = (float*)(P.ws + OFF_LSE);
  __syncthreads();
  for (int i = tid; i < 32 * AT_STR / 4; i += 512) { ((LAS unsigned*)(lds + 384 * AT_STR))[i] = 0u; ((LAS unsigned*)(lds + AT_VOFF + 384 * AT_STR))[i] = 0u; }
  for (int item = blockIdx.x; item < 256; item += gridDim.x) {
    const int tile = item >> 4, head = item & 15, T0 = tile * 1024;
    for (int g = 0; g < 3; ++g) {
      const int lg = 2 * g, dil = 1 << lg, L = S_LEN >> lg;
      const int NP = (g == 2) ? 2 : 1, WR = 384 / NP, NQ = (g < 2) ? 2 : 1, nrounds = (g < 2) ? 4 : 8;
      const bf16_t* Qg = qkv + (size_t)((g * 3 + 0) * 16 + head) * S_LEN * 64;
      const bf16_t* Kg = qkv + (size_t)((g * 3 + 1) * 16 + head) * S_LEN * 64;
      const bf16_t* Vg = qkv + (size_t)((g * 3 + 2) * 16 + head) * S_LEN * 64;
      u32x4 pk[6], pv[6];
#define AT_LOAD(RD) do { int pb_, p0_; if (g == 0) { pb_ = 0; p0_ = T0 + 256 * (RD); } else if (g == 1) { pb_ = (RD); p0_ = T0 >> 2; } else { pb_ = 2 * (RD); p0_ = T0 >> 4; } \
        _Pragma("unroll") for (int e = 0; e < 6; ++e) { const int idx = tid + e * 512, row = idx >> 3, ch = idx & 7; \
          const int slab = (row >= WR) ? 1 : 0, rr = row - slab * WR; const int pos = p0_ - 64 + rr, tok = pos * dil + pb_ + slab; \
          pk[e] = (u32x4){0u, 0u, 0u, 0u}; pv[e] = pk[e]; \
          if (pos >= 0 && pos < L) { pk[e] = *(const u32x4*)(Kg + (size_t)tok * 64 + ch * 8); pv[e] = *(const u32x4*)(Vg + (size_t)tok * 64 + ch * 8); } } } while (0)
      AT_LOAD(0);
      for (int rd = 0; rd < nrounds; ++rd) {
        const int tid = otid(), wid = tid >> 6, lane = tid & 63, fr = lane & 15, fq = lane >> 4;
        int pbase, P0;
        if (g == 0) { pbase = 0; P0 = T0 + 256 * rd; } else if (g == 1) { pbase = rd; P0 = T0 >> 2; } else { pbase = 2 * rd; P0 = T0 >> 4; }
        LBAR;
        if (rd == 0 && g > 0) asm volatile("buffer_inv sc1" ::: "memory");
#pragma unroll
        for (int e = 0; e < 6; ++e) {
          const int idx = tid + e * 512, row = idx >> 3, ch = idx & 7;
          *(LAS u32x4*)(lds + row * AT_STR + ch * 16) = pk[e];
          *(LAS u32x4*)(lds + AT_VOFF + row * AT_STR + ch * 16) = pv[e];
        }
        const int wl = (NP == 2) ? (wid & 3) : wid, slab = (NP == 2) ? (wid >> 2) : 0, phase = pbase + slab;
        const int i0 = P0 + 16 * NQ * wl, rowbase = slab * WR + 16 * NQ * wl;
        bf16x8 qf[2][2]; unsigned long long prev[2][4]; float plse[2];
#pragma unroll
        for (int q = 0; q < 2; ++q) {
          plse[q] = 0.f;
#pragma unroll
          for (int dt = 0; dt < 4; ++dt) prev[q][dt] = 0ull;
          if (q < NQ) {
            const int qtok = (i0 + 16 * q + fr) * dil + phase;
            qf[q][0] = *(const bf16x8*)(Qg + (size_t)qtok * 64 + fq * 8);
            qf[q][1] = *(const bf16x8*)(Qg + (size_t)qtok * 64 + 32 + fq * 8);
            if (g > 0) {
              plse[q] = lse[(size_t)qtok * 16 + head];
#pragma unroll
              for (int dt = 0; dt < 4; ++dt)
                prev[q][dt] = *(const unsigned long long*)(aout + (size_t)qtok * DM + head * 64 + 4 * fq + dt * 16);
            }
          } else { qf[q][0] = (bf16x8){0, 0, 0, 0, 0, 0, 0, 0}; qf[q][1] = qf[q][0]; }
        }
        LBAR;
        if (rd + 1 < nrounds) AT_LOAD(rd + 1);
        LAS unsigned char* kb = lds + (rowbase + fr) * AT_STR + fq * 16;
        LAS unsigned char* vb = lds + AT_VOFF + (rowbase + fq * 4 + (fr >> 2)) * AT_STR + (fr & 3) * 8;
        f32x4 sc[2][9];
#pragma unroll
        for (int t = 0; t < 10; ++t) {
          const bf16x8 k0 = *(const LAS bf16x8*)(kb + t * 16 * AT_STR), k1 = *(const LAS bf16x8*)(kb + t * 16 * AT_STR + 64);
          if (t < 9) { f32x4 a = (f32x4){0.f, 0.f, 0.f, 0.f}; a = mfma16(k0, qf[0][0], a); a = mfma16(k1, qf[0][1], a); sc[0][t] = a; }
          if (t > 0 && NQ == 2) { f32x4 a = (f32x4){0.f, 0.f, 0.f, 0.f}; a = mfma16(k0, qf[1][0], a); a = mfma16(k1, qf[1][1], a); sc[1][t - 1] = a; }
          if (t == 3 || t == 6) SCHED;
        }
        SCHED;
        const bool edge = (i0 < 64) || (i0 + 96 > L);
        float mxv[2], lsv[2];
#pragma unroll
        for (int q = 0; q < 2; ++q) {
          mxv[q] = 0.f; lsv[q] = 1.f;
          if (q < NQ) {
#pragma unroll
            for (int r = 0; r < 4; ++r) {
              if (4 * fq + r < fr) sc[q][0][r] = -3.0e38f;
              if (4 * fq + r > fr) sc[q][8][r] = -3.0e38f;
            }
            if (edge) {
#pragma unroll
              for (int tr = 0; tr < 9; ++tr)
#pragma unroll
                for (int r = 0; r < 4; ++r) { const int kpos = i0 - 64 + (q + tr) * 16 + 4 * fq + r; if (kpos < 0 || kpos >= L) sc[q][tr][r] = -3.0e38f; }
            }
            float mx = -3.0e38f;
#pragma unroll
            for (int tr = 0; tr < 9; ++tr) mx = fmaxf(mx, fmaxf(fmaxf(sc[q][tr][0], sc[q][tr][1]), fmaxf(sc[q][tr][2], sc[q][tr][3])));
            mx = fmaxf(mx, __shfl_xor(mx, 16)); mx = fmaxf(mx, __shfl_xor(mx, 32));
            float lsum = 0.f;
#pragma unroll
            for (int tr = 0; tr < 9; ++tr)
#pragma unroll
              for (int r = 0; r < 4; ++r) { const float p = fast_exp2(sc[q][tr][r] - mx); sc[q][tr][r] = p; lsum += p; }
            lsum += __shfl_xor(lsum, 16); lsum += __shfl_xor(lsum, 32);
            mxv[q] = mx; lsv[q] = lsum;
          }
        }
        f32x4 oacc[2][4];
#pragma unroll
        for (int q = 0; q < 2; ++q)
#pragma unroll
          for (int dt = 0; dt < 4; ++dt) oacc[q][dt] = (f32x4){0.f, 0.f, 0.f, 0.f};
#pragma unroll
        for (int ks = 0; ks < 5; ++ks) {
          bf16x8 pf0, pf1;
          {
            const unsigned a0 = cvt_pk(sc[0][2 * ks][0], sc[0][2 * ks][1]), a1 = cvt_pk(sc[0][2 * ks][2], sc[0][2 * ks][3]);
            unsigned b0 = 0u, b1 = 0u;
            if (ks < 4) { b0 = cvt_pk(sc[0][2 * ks + 1][0], sc[0][2 * ks + 1][1]); b1 = cvt_pk(sc[0][2 * ks + 1][2], sc[0][2 * ks + 1][3]); }
            u32x4 w = (u32x4){a0, a1, b0, b1}; pf0 = *(bf16x8*)&w; }
          pf1 = (bf16x8){0, 0, 0, 0, 0, 0, 0, 0};
          if (NQ == 2) {
            unsigned a0 = 0u, a1 = 0u;
            if (ks > 0) { a0 = cvt_pk(sc[1][2 * ks - 1][0], sc[1][2 * ks - 1][1]); a1 = cvt_pk(sc[1][2 * ks - 1][2], sc[1][2 * ks - 1][3]); }
            const unsigned b0 = cvt_pk(sc[1][2 * ks][0], sc[1][2 * ks][1]), b1 = cvt_pk(sc[1][2 * ks][2], sc[1][2 * ks][3]);
            u32x4 w = (u32x4){a0, a1, b0, b1}; pf1 = *(bf16x8*)&w; }
#pragma unroll
          for (int dt = 0; dt < 4; ++dt) {
            const bf16x8 vf = tr_pair(vb + (ks * 32) * AT_STR + dt * 32, vb + (ks * 32 + 16) * AT_STR + dt * 32);
            oacc[0][dt] = mfma16(vf, pf0, oacc[0][dt]);
            if (NQ == 2) oacc[1][dt] = mfma16(vf, pf1, oacc[1][dt]);
          }
          SCHED;
        }
#pragma unroll
        for (int q = 0; q < 2; ++q) {
          if (q < NQ) {
            const int qtok = (i0 + 16 * q + fr) * dil + phase;
            const float inv = fast_rcp(lsv[q]);
            float l2 = mxv[q] + fast_log2(lsv[q]);
            bf16_t* op = aout + (size_t)qtok * DM + head * 64 + 4 * fq;
            float* lp = lse + (size_t)qtok * 16 + head;
            float w2 = 1.f, w1 = 0.f;
            if (g > 0) {
              const float lr = plse[q];
              const float M = fmaxf(lr, l2);
              const float e1 = fast_exp2(lr - M), e2 = fast_exp2(l2 - M), isum = fast_rcp(e1 + e2);
              w1 = e1 * isum; w2 = e2 * isum; l2 = M + fast_log2(e1 + e2);
            }
#pragma unroll
            for (int dt = 0; dt < 4; ++dt) {
              f32x4 o = oacc[q][dt] * (inv * w2);
              if (g > 0) {
                const unsigned long long pvv = prev[q][dt];
                const unsigned lo = (unsigned)pvv, hi = (unsigned)(pvv >> 32);
                o[0] += w1 * __uint_as_float(lo << 16); o[1] += w1 * __uint_as_float(lo & 0xffff0000u);
                o[2] += w1 * __uint_as_float(hi << 16); o[3] += w1 * __uint_as_float(hi & 0xffff0000u);
              }
              u32x2 w; w.x = cvt_pk(o[0], o[1]); w.y = cvt_pk(o[2], o[3]);
              *(u32x2*)(op + dt * 16) = w;
            }
            if (fq == 0) *lp = l2;
          }
        }
      }
      asm volatile("s_waitcnt vmcnt(0)" ::: "memory");
    }
  }
  __syncthreads();
}

constexpr int GL_ST = 0, GL_STS = 272, GL_V = 69632, GL_VS = 560, GL_Q = GL_V + 64 * GL_VS  , GL_QS = 272, GL_K = GL_Q + 64 * GL_QS  ,
              GL_A = GL_K + 64 * GL_QS  , GL_AS = 144, GL_TOT = GL_A + 64 * GL_AS  , GL_DEC = GL_TOT + 2048, GL_RED = GL_DEC + 512;
static_assert(GL_RED + 2048 <= LDS_BYTES, "lds");

DI float logsig16(float z) { return (fminf(z, 0.f) - __logf(1.0f + __expf(-fabsf(z)))) * (1.0f / 16.0f); }
DI void gla_gate_phase(const Params& P, LAS unsigned char* lds, int lj) {
  const int tid = otid(), h = tid >> 7, dcol = tid & 127, col = h * 128 + dcol;
  bf16_t* proj = (bf16_t*)(P.ws + OFF_PROJ);
  const float* zbuf = (const float*)(P.ws + OFF_Z);
  bf16_t* QB = (bf16_t*)(P.ws + OFF_HB); bf16_t* KB = QB + (size_t)T_TOK * 512;
  float* dect = (float*)(P.ws + OFF_DEC);
  const float* Wf = P.in[8] + (size_t)lj * 16 * 512; const float* Wb = P.in[10] + (size_t)lj * 16 * 512;
  float wf[16], wb[16];
#pragma unroll
  for (int j = 0; j < 16; ++j) { wf[j] = Wf[j * 512 + col]; wb[j] = Wb[j * 512 + col]; }
  const float bf_ = P.in[9][(size_t)lj * 512 + col], bb_ = P.in[11][(size_t)lj * 512 + col];
  LAS float* zL = (LAS float*)lds;
  for (int item = blockIdx.x; item < 512; item += gridDim.x) {
    __syncthreads();
    { const int row = tid >> 3, part = tid & 7; *(LAS f32x4*)(zL + row * 32 + part * 4) = *(const f32x4*)(zbuf + ((size_t)item * 64 + row) * 32 + part * 4); }
    __syncthreads();
    float lsb[64]; float totb = 0.f;
#pragma unroll
    for (int i = 0; i < 64; ++i) {
      float z = bb_;
#pragma unroll
      for (int j4 = 0; j4 < 4; ++j4) { const f32x4 zz = *(const LAS f32x4*)(zL + i * 32 + 16 + j4 * 4); z += zz[0] * wb[j4 * 4] + zz[1] * wb[j4 * 4 + 1] + zz[2] * wb[j4 * 4 + 2] + zz[3] * wb[j4 * 4 + 3]; }
      lsb[i] = logsig16(z); totb += lsb[i];
    }
    float runf = 0.f, runb = 0.f;
#pragma unroll
    for (int ib = 0; ib < 4; ++ib) {
      bf16_t qraw[16], kraw[16];
#pragma unroll
      for (int ii = 0; ii < 16; ++ii) { const bf16_t* pr = proj + ((size_t)item * 64 + ib * 16 + ii) * 3072 + col; qraw[ii] = pr[0]; kraw[ii] = pr[512]; }
      asm volatile("" ::: "memory");
#pragma unroll
      for (int ii = 0; ii < 16; ++ii) {
        const int i = ib * 16 + ii;
        float z = bf_;
#pragma unroll
        for (int j4 = 0; j4 < 4; ++j4) { const f32x4 zz = *(const LAS f32x4*)(zL + i * 32 + j4 * 4); z += zz[0] * wf[j4 * 4] + zz[1] * wf[j4 * 4 + 1] + zz[2] * wf[j4 * 4 + 2] + zz[3] * wf[j4 * 4 + 3]; }
        runf += logsig16(z);
        const float Bi = totb - runb; runb += lsb[i];
        const size_t tokrow = (size_t)item * 64 + i;
        bf16_t* pr = proj + tokrow * 3072 + col;
        const float q = bf2f(qraw[ii]), k = bf2f(kraw[ii]);
        pr[0] = f2bf(q * __expf(runf)); pr[512] = f2bf(k * __expf(-runf));
        QB[tokrow * 512 + col] = f2bf(q * __expf(Bi)); KB[tokrow * 512 + col] = f2bf(k * __expf(-Bi));
      }
      asm volatile("" ::: "memory");
    }
    dect[(size_t)item * 512 + col] = __expf(runf);
    dect[(size_t)(512 + item) * 512 + col] = __expf(totb);
  }
  __syncthreads();
}

template <int MODE>
DI void gla_walk(const Params& P, LAS unsigned char* lds, int lj, int b, int h, int dir, int seg, f32x4 (&accS)[8][2], float& dprod) {
  const bf16_t* proj = (const bf16_t*)(P.ws + OFF_PROJ);
  bf16_t* gated = (bf16_t*)(P.ws + OFF_GATED);
  const float* dect = (const float*)(P.ws + OFF_DEC) + (size_t)dir * 512 * 512 + (size_t)b * 256 * 512 + h * 128;
  const float* ogain = P.in[12] + (size_t)lj * 1024 + h * 256;
  const size_t tokbase = (size_t)b * S_LEN;
  const int qstr = dir ? 512 : 3072;
  const bf16_t* qsrc = (dir ? (const bf16_t*)(P.ws + OFF_HB) + h * 128 : proj + h * 128) + tokbase * qstr;
  const bf16_t* ksrc = (dir ? (const bf16_t*)(P.ws + OFF_HB) + (size_t)T_TOK * 512 + h * 128 : proj + 512 + h * 128) + tokbase * qstr;
  const bf16_t* vsrc = proj + 1024 + h * 256 + tokbase * 3072;
  bf16_t* gbase = gated + tokbase * DM + h * 256;
  const bf16_t* rbase = proj + tokbase * 3072 + 2048 + h * 256;
  LAS float* DEC = (LAS float*)(lds + GL_DEC);
  LAS float* RED = (LAS float*)(lds + GL_RED);
  u32x4 pk[2], pq[2], pv[4]; float pdec = 1.f;
  f32x4 gnv[2];
  { const int t0_ = otid(); gnv[0] = *(const f32x4*)(ogain + (2 * (t0_ >> 6) + 0) * 16 + 4 * ((t0_ & 63) >> 4)); gnv[1] = *(const f32x4*)(ogain + (2 * (t0_ >> 6) + 1) * 16 + 4 * ((t0_ & 63) >> 4)); }
#define GL_LOAD(CC) do { const int t_ = otid(); const int ch_ = dir ? (seg * CPS + CPS - 1 - (CC)) : (seg * CPS + (CC)); const int c0_ = ch_ * 64; \
    _Pragma("unroll") for (int e = 0; e < 2; ++e) { const int idx = t_ + e * 512, i = idx >> 4, cx = idx & 15, tok = dir ? (c0_ + 63 - i) : (c0_ + i); \
      const unsigned o_ = (unsigned)(tok * qstr + cx * 8); pk[e] = *(const u32x4*)(ksrc + o_); if (MODE != 0) pq[e] = *(const u32x4*)(qsrc + o_); } \
    _Pragma("unroll") for (int e = 0; e < 4; ++e) { const int idx = t_ + e * 512, i = idx >> 5, cx = idx & 31, tok = dir ? (c0_ + 63 - i) : (c0_ + i); \
      pv[e] = *(const u32x4*)(vsrc + (unsigned)(tok * 3072 + cx * 8)); } \
    pdec = dect[(size_t)ch_ * 512 + (t_ & 127)]; } while (0)
  GL_LOAD(0);
  for (int cc = 0; cc < CPS; ++cc) {
    const int tid = otid(), wid = tid >> 6, lane = tid & 63, fr = lane & 15, fq = lane >> 4;
    const int c0 = (dir ? (seg * CPS + CPS - 1 - cc) : (seg * CPS + cc)) * 64;
    LBAR;
#pragma unroll
    for (int e = 0; e < 2; ++e) { const int idx = tid + e * 512, i = idx >> 4, cx = idx & 15;
      *(LAS u32x4*)(lds + GL_K + i * GL_QS + cx * 16) = pk[e]; if (MODE != 0) *(LAS u32x4*)(lds + GL_Q + i * GL_QS + cx * 16) = pq[e]; }
#pragma unroll
    for (int e = 0; e < 4; ++e) { const int idx = tid + e * 512, i = idx >> 5, cx = idx & 31; *(LAS u32x4*)(lds + GL_V + i * GL_VS + cx * 16) = pv[e]; }
    if (tid < 128) { DEC[tid] = pdec; dprod *= pdec; }
    LBAR;
    GL_LOAD((cc + 1 < CPS) ? cc + 1 : cc);
    unsigned long long pof[2][4]; u32x2 prv[2][4];
    if (MODE == 2) {
#pragma unroll
      for (int tt = 0; tt < 4; ++tt)
#pragma unroll
        for (int et2 = 0; et2 < 2; ++et2)
          prv[et2][tt] = *(const u32x2*)(rbase + (unsigned)((c0 + 63 - (tt * 16 + fr)) * 3072 + (2 * wid + et2) * 16 + 4 * fq));
#pragma unroll
      for (int tt = 0; tt < 4; ++tt)
#pragma unroll
        for (int et2 = 0; et2 < 2; ++et2)
          pof[et2][tt] = *(const unsigned long long*)(gbase + (unsigned)((c0 + 63 - (tt * 16 + fr)) * DM + (2 * wid + et2) * 16 + 4 * fq));
    }
    if (MODE != 0) {
      const int st = wid >> 1;
#pragma unroll
      for (int t2 = 0; t2 < 2; ++t2) {
        const int tt = 2 * (wid & 1) + t2;
        f32x4 a = (f32x4){0.f, 0.f, 0.f, 0.f};
        if (st <= tt) {
#pragma unroll
          for (int ks = 0; ks < 4; ++ks)
            a = mfma16(*(const LAS bf16x8*)(lds + GL_K + (st * 16 + fr) * GL_QS + ks * 64 + fq * 16),
                       *(const LAS bf16x8*)(lds + GL_Q + (tt * 16 + fr) * GL_QS + ks * 64 + fq * 16), a);
          const int tcol = tt * 16 + fr;
#pragma unroll
          for (int r = 0; r < 4; ++r) { const int s = st * 16 + 4 * fq + r; const bool keep = dir ? (s < tcol) : (s <= tcol); a[r] = keep ? a[r] : 0.f; }
        }
        u32x2 w; w.x = cvt_pk(a[0], a[1]); w.y = cvt_pk(a[2], a[3]);
        *(LAS u32x2*)(lds + GL_A + (tt * 16 + fr) * GL_AS + (st * 16 + 4 * fq) * 2) = w;
      }
      LBAR;
    }
    bf16x8 vf[2][2];
#pragma unroll
    for (int et2 = 0; et2 < 2; ++et2)
#pragma unroll
      for (int ks = 0; ks < 2; ++ks) {
        LAS unsigned char* p = lds + GL_V + (ks * 32 + 8 * fq + (fr >> 2)) * GL_VS + ((2 * wid + et2) * 16 + 4 * (fr & 3)) * 2;
        vf[et2][ks] = tr_pair(p, p + 4 * GL_VS);
      }
    if (MODE != 0) {
      f32x4 accO[2][4];
#pragma unroll
      for (int et2 = 0; et2 < 2; ++et2)
#pragma unroll
        for (int tt = 0; tt < 4; ++tt) accO[et2][tt] = (f32x4){0.f, 0.f, 0.f, 0.f};
#pragma unroll
      for (int tt = 0; tt < 4; ++tt) {
#pragma unroll
        for (int ks = 0; ks < 2; ++ks) {
          const bf16x8 af = *(const LAS bf16x8*)(lds + GL_A + (tt * 16 + fr) * GL_AS + ks * 64 + fq * 16);
          accO[0][tt] = mfma16(vf[0][ks], af, accO[0][tt]);
          accO[1][tt] = mfma16(vf[1][ks], af, accO[1][tt]);
        }
#pragma unroll
        for (int ks = 0; ks < 4; ++ks) {
          const bf16x8 qf = *(const LAS bf16x8*)(lds + GL_Q + (tt * 16 + fr) * GL_QS + ks * 64 + fq * 16);
#pragma unroll
          for (int et2 = 0; et2 < 2; ++et2) {
            const bf16x8 sf = *(const LAS bf16x8*)(lds + GL_ST + ((2 * wid + et2) * 16 + fr) * GL_STS + ks * 64 + fq * 16);
            accO[et2][tt] = mfma16(sf, qf, accO[et2][tt]);
          }
        }
        SCHED;
      }
      if (MODE == 1) {
#pragma unroll
        for (int tt = 0; tt < 4; ++tt) {
          const int t = tt * 16 + fr, tok = c0 + t;
#pragma unroll
          for (int et2 = 0; et2 < 2; ++et2) {
            u32x2 w; w.x = cvt_pk(accO[et2][tt][0], accO[et2][tt][1]); w.y = cvt_pk(accO[et2][tt][2], accO[et2][tt][3]);
            *(u32x2*)(gbase + (unsigned)(tok * DM + (2 * wid + et2) * 16 + 4 * fq)) = w;
          }
        }
      } else {
#pragma unroll
        for (int tt = 0; tt < 4; ++tt) {
          const int t = tt * 16 + fr;
          float q = 0.f;
#pragma unroll
          for (int et2 = 0; et2 < 2; ++et2) {
            const unsigned long long pvv = pof[et2][tt];
            const unsigned lo = (unsigned)pvv, hi = (unsigned)(pvv >> 32);
            f32x4 o = accO[et2][tt];
            o[0] += __uint_as_float(lo << 16); o[1] += __uint_as_float(lo & 0xffff0000u); o[2] += __uint_as_float(hi << 16); o[3] += __uint_as_float(hi & 0xffff0000u);
            accO[et2][tt] = o;
            q += o[0] * o[0] + o[1] * o[1] + o[2] * o[2] + o[3] * o[3];
          }
          q += __shfl_xor(q, 16); q += __shfl_xor(q, 32);
          if (fq == 0) RED[wid * 64 + t] = q;
        }
        LBAR;
#pragma unroll
        for (int tt = 0; tt < 4; ++tt) {
          const int t = tt * 16 + fr, tok = c0 + 63 - t;
          float q = 0.f;
#pragma unroll
          for (int w8 = 0; w8 < 8; ++w8) q += RED[w8 * 64 + t];
          const float rn = rsqrtf(q * (1.0f / 256.0f) + EPS);
#pragma unroll
          for (int et2 = 0; et2 < 2; ++et2) {
            const int e0 = (2 * wid + et2) * 16 + 4 * fq;
            const f32x4 gn = gnv[et2];
            const u32x2 rv = prv[et2][tt];
            float rr[4] = {__uint_as_float(rv.x << 16), __uint_as_float(rv.x & 0xffff0000u), __uint_as_float(rv.y << 16), __uint_as_float(rv.y & 0xffff0000u)};
            float o[4];
#pragma unroll
            for (int r = 0; r < 4; ++r) o[r] = accO[et2][tt][r] * rn * gn[r] * (rr[r] * fast_rcp(1.0f + fast_exp(-rr[r])));
            u32x2 w; w.x = cvt_pk(o[0], o[1]); w.y = cvt_pk(o[2], o[3]);
            *(u32x2*)(gbase + (unsigned)(tok * DM + e0)) = w;
          }
          SCHED;
        }
      }
    }
#pragma unroll
    for (int dt = 0; dt < 8; ++dt) {
#pragma unroll
      for (int ks = 0; ks < 2; ++ks) {
        LAS unsigned char* p = lds + GL_K + (ks * 32 + 8 * fq + (fr >> 2)) * GL_QS + (dt * 16 + 4 * (fr & 3)) * 2;
        const bf16x8 kf = tr_pair(p, p + 4 * GL_QS);
        accS[dt][0] = mfma16(kf, vf[0][ks], accS[dt][0]);
        accS[dt][1] = mfma16(kf, vf[1][ks], accS[dt][1]);
      }
      const f32x4 dc = *(const LAS f32x4*)(lds + GL_DEC + (dt * 16 + 4 * fq) * 4);
#pragma unroll
      for (int et2 = 0; et2 < 2; ++et2) {
        accS[dt][et2] = accS[dt][et2] * dc;
        if (MODE != 0) {
          u32x2 w; w.x = cvt_pk(accS[dt][et2][0], accS[dt][et2][1]); w.y = cvt_pk(accS[dt][et2][2], accS[dt][et2][3]);
          *(LAS u32x2*)(lds + GL_ST + ((2 * wid + et2) * 16 + fr) * GL_STS + (dt * 16 + 4 * fq) * 2) = w;
        }
      }
      if (dt & 1) SCHED;
    }
  }
  LBAR;
}

DI void gla_sum_phase(const Params& P, LAS unsigned char* lds, int lj) {
  const int tid = otid(), wid = tid >> 6, lane = tid & 63;
  float* state = (float*)(P.ws + OFF_STATE);
  float* dseg = (float*)(P.ws + OFF_DSEG);
  __syncthreads();
  for (int item = blockIdx.x; item < 16 * NSEG; item += gridDim.x) {
    const int seg = item % NSEG, dir = (item / NSEG) & 1, bh = item / (2 * NSEG);
    f32x4 accS[8][2];
#pragma unroll
    for (int dt = 0; dt < 8; ++dt) { accS[dt][0] = (f32x4){0.f, 0.f, 0.f, 0.f}; accS[dt][1] = accS[dt][0]; }
    float dprod = 1.f;
    gla_walk<0>(P, lds, lj, bh >> 2, bh & 3, dir, seg, accS, dprod);
    float* sp = state + ((size_t)(bh * 2 + dir) * NSEG + seg) * 32768 + wid * 4096 + lane;
#pragma unroll
    for (int dt = 0; dt < 8; ++dt)
#pragma unroll
      for (int et2 = 0; et2 < 2; ++et2)
#pragma unroll
        for (int r = 0; r < 4; ++r) sp[((dt * 2 + et2) * 4 + r) * 64] = accS[dt][et2][r];
    if (tid < 128) dseg[((size_t)(bh * 2 + dir) * NSEG + seg) * 128 + tid] = dprod;
  }
}
DI void gla_scan_phase(const Params& P) {
  float* state = (float*)(P.ws + OFF_STATE);
  const float* dseg = (const float*)(P.ws + OFF_DSEG);
  const int gtid = blockIdx.x * 512 + otid(), gn = gridDim.x * 512;
  for (int i = gtid; i < 16 * 32768; i += gn) {
    const int e = i & 32767, bd = i >> 15, dir = bd & 1;
    const int reg = (e >> 6) & 63, d = (reg >> 3) * 16 + 4 * ((e & 63) >> 4) + (reg & 3);
    float loc[NSEG], dc[NSEG];
#pragma unroll
    for (int s2 = 0; s2 < NSEG; ++s2) {
      const int seg = dir ? (NSEG - 1 - s2) : s2;
      loc[s2] = state[((size_t)bd * NSEG + seg) * 32768 + e];
      dc[s2] = dseg[((size_t)bd * NSEG + seg) * 128 + d];
    }
    float run = 0.f;
#pragma unroll
    for (int s2 = 0; s2 < NSEG; ++s2) {
      const int seg = dir ? (NSEG - 1 - s2) : s2;
      state[((size_t)bd * NSEG + seg) * 32768 + e] = run;
      run = dc[s2] * run + loc[s2];
    }
  }
}
DI void gla_load_state(const float* sp, LAS unsigned char* lds, f32x4 (&accS)[8][2], int wid, int fr, int fq) {
#pragma unroll
  for (int dt = 0; dt < 8; ++dt)
#pragma unroll
    for (int et2 = 0; et2 < 2; ++et2) {
#pragma unroll
      for (int r = 0; r < 4; ++r) accS[dt][et2][r] = sp[((dt * 2 + et2) * 4 + r) * 64];
      u32x2 w; w.x = cvt_pk(accS[dt][et2][0], accS[dt][et2][1]); w.y = cvt_pk(accS[dt][et2][2], accS[dt][et2][3]);
      *(LAS u32x2*)(lds + GL_ST + ((2 * wid + et2) * 16 + fr) * GL_STS + (dt * 16 + 4 * fq) * 2) = w;
    }
}
DI void gla_out_phase(const Params& P, LAS unsigned char* lds, int lj) {
  const float* state = (const float*)(P.ws + OFF_STATE);
  __syncthreads();
  for (int item = blockIdx.x; item < 8 * NSEG; item += gridDim.x) {
    const int seg = item % NSEG, bh = item / NSEG;
    {
      const int tid = otid(), wid = tid >> 6, lane = tid & 63, fr = lane & 15, fq = lane >> 4;
      f32x4 accS[8][2]; float dprod = 1.f;
      gla_load_state(state + ((size_t)(bh * 2 + 0) * NSEG + seg) * 32768 + wid * 4096 + lane, lds, accS, wid, fr, fq);
      gla_walk<1>(P, lds, lj, bh >> 2, bh & 3, 0, seg, accS, dprod);
    }
    asm volatile("s_waitcnt vmcnt(0)" ::: "memory");
    __syncthreads();
    asm volatile("buffer_inv sc1" ::: "memory");
    {
      const int tid = otid(), wid = tid >> 6, lane = tid & 63, fr = lane & 15, fq = lane >> 4;
      f32x4 accS[8][2]; float dprod = 1.f;
      gla_load_state(state + ((size_t)(bh * 2 + 1) * NSEG + seg) * 32768 + wid * 4096 + lane, lds, accS, wid, fr, fq);
      gla_walk<2>(P, lds, lj, bh >> 2, bh & 3, 1, seg, accS, dprod);
    }
    __syncthreads();
  }
}


#define XB_TMO      128
#define XB_XCNT(j)  (256  + 64 * (j))
#define XB_XSUB(j)  (1280 + 64 * (j))
#define XB_XGEN(j)  (2304 + 64 * (j))
#define XB_TOP      3328
#define XB_TOPGEN   3392
#define XCD_BAR_WORDS 3456
#define XB_SPIN_CAP (1u << 20)
DI unsigned xb_ld(unsigned* p)              { return __hip_atomic_load(p, __ATOMIC_RELAXED, __HIP_MEMORY_SCOPE_AGENT); }
DI unsigned xb_add(unsigned* p, unsigned v) { return __hip_atomic_fetch_add(p, v, __ATOMIC_RELAXED, __HIP_MEMORY_SCOPE_AGENT); }
DI unsigned xb_xcc_id() { return (unsigned)__builtin_amdgcn_s_getreg((3 << 11) | 20) & 0xFu; }
#define XB_SPIN(cond, bar) do { unsigned _sp = 0; while (cond) { __builtin_amdgcn_s_sleep(1); \
    if ((++_sp & 255u) == 0u) { if (xb_ld(&(bar)[XB_TMO])) break; if (_sp > XB_SPIN_CAP) { atomicAdd(&(bar)[XB_TMO], 1u); break; } } } } while (0)
struct XcdBarrier { unsigned* bar; unsigned x; volatile LAS unsigned* st; };
DI XcdBarrier xcd_barrier_post(unsigned* bar, volatile LAS unsigned* st) {
  XcdBarrier b; b.bar = bar; b.x = xb_xcc_id(); b.st = st;
  if (threadIdx.x == 0) (void)xb_add(&bar[XB_XCNT(b.x)], 1u);
  return b;
}
DI void xcd_barrier_complete(unsigned* bar, unsigned x, unsigned& nloc, unsigned& nx) {
  const unsigned G = gridDim.x * gridDim.y * gridDim.z;
  unsigned sum, cnt, mine, sp = 0u;
  for (;;) {
    sum = 0u; cnt = 0u; mine = 0u;
#pragma unroll
    for (unsigned j = 0; j < 16; ++j) { const unsigned c = xb_ld(&bar[XB_XCNT(j)]); sum += c; cnt += (c > 0u) ? 1u : 0u; mine = (j == x) ? c : mine; }
    if (sum == G) break;
    __builtin_amdgcn_s_sleep(1);
    if ((++sp & 255u) == 0u) { if (xb_ld(&bar[XB_TMO])) break; if (sp > XB_SPIN_CAP) { atomicAdd(&bar[XB_TMO], 1u); break; } }
  }
  nloc = mine > 0u ? mine : 1u; nx = cnt > 0u ? cnt : 1u;
}
DI void xcd_barrier(const XcdBarrier& b) {
  asm volatile("s_waitcnt vmcnt(0)" ::: "memory");
  __syncthreads();
  if (threadIdx.x == 0) {
    unsigned* bar = b.bar;
    __builtin_amdgcn_s_waitcnt(0);
    unsigned nloc = b.st[0], nx = b.st[1];
    if (nloc == 0u) { xcd_barrier_complete(bar, b.x, nloc, nx); b.st[0] = nloc; b.st[1] = nx; }
    const unsigned old = xb_add(&bar[XB_XSUB(b.x)], 1u);
    const unsigned gen = old / nloc;
    if (old + 1u == (gen + 1u) * nloc) {
      __builtin_amdgcn_fence(__ATOMIC_RELEASE, "agent");
      asm volatile("s_waitcnt vmcnt(0)" ::: "memory");
      const unsigned og = xb_add(&bar[XB_TOP], 1u);
      const unsigned tg = og / nx;
      if (og + 1u == (tg + 1u) * nx) xb_add(&bar[XB_TOPGEN], 1u);
      else XB_SPIN(xb_ld(&bar[XB_TOPGEN]) == tg, bar);
      __builtin_amdgcn_fence(__ATOMIC_ACQUIRE, "agent");
      xb_add(&bar[XB_XGEN(b.x)], 1u);
      asm volatile("s_waitcnt vmcnt(0)" ::: "memory");
    } else {
      XB_SPIN(xb_ld(&bar[XB_XGEN(b.x)]) == gen, bar);
      __builtin_amdgcn_fence(__ATOMIC_ACQUIRE, "agent");
      asm volatile("s_waitcnt vmcnt(0)" ::: "memory");
    }
  }
  __syncthreads();
}

#ifndef PM
#define PM 0xFFFF
#endif
DI void run_phase(const Params& P, LAS unsigned char* lds, int ph) {
  unsigned char* ws = P.ws;
  bf16_t* hb = (bf16_t*)(ws + OFF_HB);
  if (ph == 0) { if (PM & 1) prep_phase(P, lds); return; }
  int li, sub;
  if (ph < 8) { li = 0; sub = ph - 1; } else if (ph < 16) { li = 1; sub = ph - 8; } else if (ph < 23) { li = 2; sub = ph - 16; } else { li = 3; sub = ph - 23; }
  const int lj = li >> 1;
  const bool isB = (li & 1) != 0;
  const int kind = isB ? (sub < 5 ? 0 : sub - 4) : (sub < 4 ? 0 : sub - 3);
  const bf16_t* W = (const bf16_t*)(ws + OFF_W0 + (size_t)(li & 1) * W_BYTES);
  if (kind == 2) { if (!(PM & 2)) return;
    EpiSwiglu e{(bf16_t*)(ws + OFF_ACT), (const float*)(ws + OFF_SS + SS_BYTES)};
    gemm_phase(lds, hb, W + W_GU, T_TOK, 2 * FFN_H, DM, e);
  } else if (kind == 3) { if (!(PM & 4)) return;
    EpiRes e{P.out, P.out, hb, (li < 3) ? (float*)(ws + OFF_SS) : nullptr};
    gemm_phase(lds, (const bf16_t*)(ws + OFF_ACT), W + W_DN, T_TOK, DM, FFN_H, e);
  } else if (kind == 1) { if (!(PM & 4)) return;
    EpiRes e{(li == 0) ? P.in[0] : P.out, P.out, hb, (float*)(ws + OFF_SS + SS_BYTES)};
    const bf16_t* Ain = isB ? (const bf16_t*)(ws + OFF_GATED) : (const bf16_t*)(ws + OFF_AOUT);
    gemm_phase(lds, Ain, W + W_OUT, T_TOK, DM, DM, e);
    if (li < 3) convert_layer(P, lds, li + 1);
  } else if (!isB) {
    const int b = sub >> 1;
    if ((sub & 1) == 0) { if (!(PM & 8)) return;
      EpiQKV e{(bf16_t*)(ws + OFF_QKV), (const float*)(ws + OFF_SS) + (size_t)b * S_LEN * 4, P.in[4] + lj * 192, P.in[5] + lj * 192,
               (const float*)(ws + OFF_COS), (const float*)(ws + OFF_SIN)};
      gemm_phase(lds, hb + (size_t)b * S_LEN * DM, W + W_IN, S_LEN, 9216, DM, e);
    } else if (PM & 16) attn_phase(P, lds, b);
  } else {
    if (sub == 0) { if (!(PM & 32)) return;
      EpiProj e{(bf16_t*)(ws + OFF_PROJ), (float*)(ws + OFF_Z), (const float*)(ws + OFF_SS)};
      gemm_phase(lds, hb, W + W_IN, T_TOK, 3328, DM, e);
    } else if (sub == 1) { if (PM & 512) gla_gate_phase(P, lds, lj); }
    else if (sub == 2) { if (PM & 64) gla_sum_phase(P, lds, lj); }
    else if (sub == 3) { if (PM & 128) gla_scan_phase(P); }
    else if (PM & 256) gla_out_phase(P, lds, lj);
  }
}

__global__ void __launch_bounds__(512, 2) mega_fwd(Params P) {
  extern __shared__ __attribute__((aligned(16))) unsigned char lds_raw[];
  LAS unsigned char* lds = (LAS unsigned char*)lds_raw;
  cg::grid_group grid = cg::this_grid();
  volatile LAS unsigned* xst = (volatile LAS unsigned*)(lds + LDS_BYTES - 16);
  if (threadIdx.x == 0) { xst[0] = 0u; xst[1] = 0u; }
  __syncthreads();
  const XcdBarrier xb = xcd_barrier_post((unsigned*)(P.ws + OFF_BAR), xst);
  for (int ph = P.ph_lo; ph < P.ph_hi; ++ph) {
    if (ph > P.ph_lo) { if (ph == P.ph_lo + 1) grid.sync(); else xcd_barrier(xb); }
    run_phase(P, lds, ph);
  }
}

extern "C" void kernel_launch(void* const* d_in, const int* in_sizes, int n_in, void* d_out, int out_size, void* d_ws, size_t ws_size,
                              hipStream_t stream) {
  static int grid = 0;
  if (grid == 0) {
    int dev = 0, cus = 0, per_cu = 0;
    hipGetDevice(&dev);
    hipDeviceGetAttribute(&cus, hipDeviceAttributeMultiprocessorCount, dev);
    if (hipFuncSetAttribute((const void*)mega_fwd, hipFuncAttributeMaxDynamicSharedMemorySize, LDS_BYTES) != hipSuccess)
      fprintf(stderr, "kernel_launch: hipFuncSetAttribute failed\n");
    if (hipOccupancyMaxActiveBlocksPerMultiprocessor(&per_cu, (const void*)mega_fwd, 512, LDS_BYTES) != hipSuccess || per_cu < 1) {
      fprintf(stderr, "kernel_launch: occupancy query says %d\n", per_cu); per_cu = 1; (void)hipGetLastError();
    }
    grid = cus * per_cu;
    if (ws_size < WS_NEED) fprintf(stderr, "kernel_launch: workspace too small: %zu < %zu\n", ws_size, (size_t)WS_NEED);
  }
  Params p{};
  for (int i = 0; i < 16; ++i) p.in[i] = (const float*)d_in[i];
  p.out = (float*)d_out; p.ws = (unsigned char*)d_ws; p.ph_lo = 0; p.ph_hi = NPHASES;
  (void)hipMemsetAsync((unsigned char*)d_ws + OFF_BAR, 0, XCD_BAR_WORDS * sizeof(unsigned), stream);
  void* args[] = {&p};
  hipError_t e = hipLaunchCooperativeKernel((const void*)mega_fwd, dim3(grid), dim3(512), args, LDS_BYTES, stream);
  if (e != hipSuccess) fprintf(stderr, "kernel_launch: cooperative launch failed: %s (grid %d)\n", hipGetErrorString(e), grid);
}
```

```cpp
#include <hip/hip_runtime.h>
#include <hip/hip_cooperative_groups.h>
#include <cstdio>
#include <cstdint>
namespace cg = cooperative_groups;

#define DI __device__ __forceinline__
#define LAS __attribute__((address_space(3)))
typedef unsigned short bf16_t;
typedef short bf16x8 __attribute__((ext_vector_type(8)));
typedef short s16x4 __attribute__((ext_vector_type(4)));
typedef float f32x4 __attribute__((ext_vector_type(4)));
typedef unsigned u32x4 __attribute__((ext_vector_type(4)));
typedef unsigned u32x2 __attribute__((ext_vector_type(2)));

constexpr int T_TOK = 32768, S_LEN = 16384, DM = 1024, FFN_H = 2816;
constexpr float EPS = 1e-6f;
constexpr float LOG2E = 1.4426950408889634f;
constexpr int NPHASES = 31;
constexpr int LDS_BYTES = 155648;
constexpr int NSEG = 32, CPS = 8;

constexpr size_t MiB = 1048576;
constexpr size_t OFF_SS = 0, SS_BYTES = 2 * MiB, OFF_COS = 4 * MiB, OFF_SIN = 6 * MiB, OFF_LSE = 8 * MiB, OFF_Z = 9 * MiB, OFF_DSEG = 13 * MiB, OFF_DEC = 14 * MiB;
constexpr size_t OFF_W0 = 16 * MiB, W_BYTES = 37 * MiB, OFF_HB = 90 * MiB, OFF_R = 154 * MiB;
constexpr size_t OFF_QKV = OFF_R, OFF_AOUT = OFF_R + 288 * MiB;
constexpr size_t OFF_PROJ = OFF_R, OFF_GATED = OFF_R + 192 * MiB, OFF_STATE = OFF_R + 256 * MiB;
constexpr size_t OFF_ACT = OFF_R;
constexpr size_t WS_NEED = 506 * MiB;
constexpr size_t OFF_BAR = OFF_DSEG + 512 * 1024;
constexpr size_t W_IN = 0, W_OUT = 9437184, W_GU = 10485760, W_DN = 16252928;

struct Params {
  const float* in[16];
  float* out;
  unsigned char* ws;
  int ph_lo, ph_hi;
};

DI float bf2f(bf16_t v) { return __uint_as_float(((unsigned)v) << 16); }
DI unsigned cvt_pk(float lo, float hi) { unsigned r; asm("v_cvt_pk_bf16_f32 %0, %1, %2" : "=v"(r) : "v"(lo), "v"(hi)); return r; }
DI bf16_t f2bf(float f) { return (bf16_t)(cvt_pk(f, 0.f) & 0xffffu); }
DI float fast_exp2(float x) { return __builtin_amdgcn_exp2f(x); }
DI float fast_log2(float x) { return __builtin_amdgcn_logf(x); }
DI float fast_rcp(float x) { return __builtin_amdgcn_rcpf(x); }
DI float fast_exp(float x) { return __builtin_amdgcn_exp2f(x * LOG2E); }
DI int otid() { int t = threadIdx.x; asm volatile("" : "+v"(t)); return t; }
DI float row_rstd(const float* ssp, size_t row) {
  const f32x4 a = *(const f32x4*)(ssp + row * 16), b = *(const f32x4*)(ssp + row * 16 + 4), c = *(const f32x4*)(ssp + row * 16 + 8), d = *(const f32x4*)(ssp + row * 16 + 12);
  const float s = (((a[0] + a[1]) + (a[2] + a[3])) + ((b[0] + b[1]) + (b[2] + b[3]))) + (((c[0] + c[1]) + (c[2] + c[3])) + ((d[0] + d[1]) + (d[2] + d[3])));
  return rsqrtf(s * (1.0f / 1024.0f) + 1e-6f);
}
DI int perm32(int p) { return 8 * ((p & 15) >> 2) + 4 * (p >> 4) + (p & 3); }
DI f32x4 mfma16(bf16x8 a, bf16x8 b, f32x4 c) { return __builtin_amdgcn_mfma_f32_16x16x32_bf16(a, b, c, 0, 0, 0); }
DI bf16x8 tr_pair(LAS unsigned char* p0, LAS unsigned char* p1) {
  s16x4 a = __builtin_amdgcn_ds_read_tr16_b64_v4i16((LAS s16x4*)p0);
  s16x4 b = __builtin_amdgcn_ds_read_tr16_b64_v4i16((LAS s16x4*)p1);
  bf16x8 f; f[0] = a[0]; f[1] = a[1]; f[2] = a[2]; f[3] = a[3]; f[4] = b[0]; f[5] = b[1]; f[6] = b[2]; f[7] = b[3];
  return f;
}

constexpr int BM = 256, BK = 64, HALF = 128;
DI int lds_byte(int r, int c) { int st = (r >> 4) * 2 + (c >> 5), rr = r & 15, cc = c & 31, ob = rr * 64 + cc * 2; return st * 1024 + (ob ^ (((ob >> 9) & 1) << 5)); }
DI void stage_rc(int b, int& R, int& C) { int st = b / 1024, sb = b % 1024, swz = sb ^ (((sb >> 9) & 1) << 5); R = (st >> 1) * 16 + swz / 64; C = (st & 1) * 32 + (swz % 64) / 2; }

#define G_SA(b, h) (((b) * 2 + (h)) * 16384)
#define G_SB(b, h) ((4 + (b) * 2 + (h)) * 16384)
#define G_STAGE(PO, BASE, br, kt) do { const bf16_t* _g = (BASE) + (long)(br) * K + (long)(kt) * BK; \
    _Pragma("unroll") for (int _i = 0; _i < 2; ++_i) \
      __builtin_amdgcn_global_load_lds((const unsigned*)(_g + soff[_i]), (LAS unsigned*)(lds + (PO) + tid * 16 + _i * 8192), 16, 0, 0); } while (0)
#define G_LDA(dst, b, h) do { _Pragma("unroll") for (int m = 0; m < 4; ++m) _Pragma("unroll") for (int k = 0; k < 2; ++k) \
    dst[m][k] = *(const LAS bf16x8*)(lds + G_SA(b, h) + aoff + m * 2048 + k * 1024); } while (0)
#define G_LDB(dst, b, h) do { _Pragma("unroll") for (int n = 0; n < 2; ++n) _Pragma("unroll") for (int k = 0; k < 2; ++k) \
    dst[n][k] = *(const LAS bf16x8*)(lds + G_SB(b, h) + boff + n * 2048 + k * 1024); } while (0)
#define G_MMA(ai, bj, At_, Bt_) do { __builtin_amdgcn_s_setprio(1); \
    _Pragma("unroll") for (int m = 0; m < 4; ++m) _Pragma("unroll") for (int n = 0; n < 2; ++n) _Pragma("unroll") for (int k = 0; k < 2; ++k) \
      acc[ai][bj][m][n] = __builtin_amdgcn_mfma_f32_16x16x32_bf16(Bt_[n][k], At_[m][k], acc[ai][bj][m][n], 0, 0, 0); \
    __builtin_amdgcn_s_setprio(0); } while (0)
#define WAIT_V(n) asm volatile("s_waitcnt vmcnt(" #n ")" ::: "memory")
#define WAIT_L(n) asm volatile("s_waitcnt lgkmcnt(" #n ")" ::: "memory")
#define BAR __builtin_amdgcn_s_barrier()
#define SCHED __builtin_amdgcn_sched_barrier(0)
#define LBAR_ do { asm volatile("s_waitcnt lgkmcnt(0)" ::: "memory"); __builtin_amdgcn_s_barrier(); asm volatile("" ::: "memory"); } while (0)

DI float rstd_of(const f32x4 s) { return rsqrtf(((s[0] + s[1]) + (s[2] + s[3])) * (1.0f / 1024.0f) + 1e-6f); }
template <class Epi>
DI void gemm_tile(LAS unsigned char* lds, const bf16_t* __restrict__ A, const bf16_t* __restrict__ Bt, const int K,
                  const int pm, const int pn, const Epi& epi, const bool first, const bool have_next, const int npm, const int npn) {
  const int tid = otid();
  const int wid = tid >> 6, lane = tid & 63, wr = wid >> 2, wc = wid & 3, fr = lane & 15, fq = lane >> 4;
  const int brow = pm * BM, bcol = pn * BM;
  long soff[2];
  { int r_, c_; stage_rc(tid * 16, r_, c_); soff[0] = (long)r_ * K + c_; stage_rc(tid * 16 + 8192, r_, c_); soff[1] = (long)r_ * K + c_; }
  const int aoff = lds_byte(wr * 64 + fr, fq * 8), boff = lds_byte(wc * 32 + fr, fq * 8);
  f32x4 acc[2][2][4][2];
#pragma unroll
  for (int a = 0; a < 2; ++a)
#pragma unroll
    for (int b = 0; b < 2; ++b)
#pragma unroll
      for (int m = 0; m < 4; ++m)
#pragma unroll
        for (int n = 0; n < 2; ++n) acc[a][b][m][n] = (f32x4){0.f, 0.f, 0.f, 0.f};
  bf16x8 At[4][2], B0[2][2], B1[2][2];
  const int nt = K / BK;
  if (first) {
    __syncthreads();
    G_STAGE(G_SB(0, 0), Bt, bcol, 0); G_STAGE(G_SA(0, 0), A, brow, 0);
    G_STAGE(G_SB(0, 1), Bt, bcol + HALF, 0); G_STAGE(G_SA(0, 1), A, brow + HALF, 0);
  }
  f32x4 svr = (f32x4){0.f, 0.f, 0.f, 0.f};
  if constexpr (Epi::RSTD) svr = *(const f32x4*)(epi.ss + (size_t)(brow + (tid & 255)) * 4);
  f32x4 pr0 = svr, pr1 = svr; float prg = 0.f;
  if constexpr (Epi::ROPE) epi.pre_load(pr0, pr1, prg, brow, pn, tid);
  if (wr == 1) BAR;
  WAIT_V(0); BAR;
  if constexpr (Epi::RSTD) ((LAS float*)(lds + 135168))[tid & 255] = rstd_of(svr);
  if constexpr (Epi::ROPE) epi.pre_store(lds, pr0, pr1, prg, tid);
  G_STAGE(G_SB(1, 0), Bt, bcol, 1); G_STAGE(G_SA(1, 0), A, brow, 1); G_STAGE(G_SB(1, 1), Bt, bcol + HALF, 1);
  WAIT_V(6); BAR;
  for (int t = 0; t < nt - 2; t += 2) {
    G_LDB(B0, 0, 0); SCHED; G_LDA(At, 0, 0); G_STAGE(G_SA(1, 1), A, brow + HALF, t + 1);
    WAIT_L(8); BAR; WAIT_L(0); G_MMA(0, 0, At, B0); BAR; SCHED;
    G_LDB(B1, 0, 1); G_STAGE(G_SB(0, 0), Bt, bcol, t + 2);
    BAR; WAIT_L(0); G_MMA(0, 1, At, B1); BAR;
    G_LDA(At, 0, 1); G_STAGE(G_SA(0, 0), A, brow, t + 2);
    BAR; WAIT_L(0); G_MMA(1, 0, At, B0); BAR; SCHED;
    G_STAGE(G_SB(0, 1), Bt, bcol + HALF, t + 2);
    WAIT_V(6); BAR; G_MMA(1, 1, At, B1); BAR;
    G_LDB(B0, 1, 0); SCHED; G_LDA(At, 1, 0); G_STAGE(G_SA(0, 1), A, brow + HALF, t + 2);
    WAIT_L(8); BAR; WAIT_L(0); G_MMA(0, 0, At, B0); BAR; SCHED;
    G_LDB(B1, 1, 1); G_STAGE(G_SB(1, 0), Bt, bcol, t + 3);
    BAR; WAIT_L(0); G_MMA(0, 1, At, B1); BAR;
    G_LDA(At, 1, 1); G_STAGE(G_SA(1, 0), A, brow, t + 3);
    BAR; WAIT_L(0); G_MMA(1, 0, At, B0); BAR; SCHED;
    G_STAGE(G_SB(1, 1), Bt, bcol + HALF, t + 3);
    WAIT_V(6); BAR; G_MMA(1, 1, At, B1); BAR;
  }
  { G_LDB(B0, 0, 0); G_LDA(At, 0, 0); G_STAGE(G_SA(1, 1), A, brow + HALF, nt - 1);
    BAR; WAIT_L(0); G_MMA(0, 0, At, B0); BAR;
    G_LDB(B1, 0, 1); BAR; WAIT_L(0); G_MMA(0, 1, At, B1); BAR;
    G_LDA(At, 0, 1); WAIT_V(4); BAR; WAIT_L(0); G_MMA(1, 0, At, B0); G_MMA(1, 1, At, B1); BAR; }
  { G_LDB(B0, 1, 0); G_LDA(At, 1, 0); WAIT_V(2); BAR;
    if (have_next) {
      const int nbrow = npm * BM, nbcol = npn * BM;
      G_STAGE(G_SB(0, 0), Bt, nbcol, 0); G_STAGE(G_SA(0, 0), A, nbrow, 0);
      G_STAGE(G_SB(0, 1), Bt, nbcol + HALF, 0); G_STAGE(G_SA(0, 1), A, nbrow + HALF, 0);
    }
    WAIT_L(0); G_MMA(0, 0, At, B0); BAR;
    G_LDB(B1, 1, 1); if (have_next) { WAIT_V(8); } else { WAIT_V(0); } BAR; WAIT_L(0); G_MMA(0, 1, At, B1); BAR;
    G_LDA(At, 1, 1); BAR; WAIT_L(0); G_MMA(1, 0, At, B0); G_MMA(1, 1, At, B1); BAR; }
  if (wr == 0) BAR;
  epi(lds, acc, pm, pn, wr, wc, fr, fq);
}

DI bool gemm_unit(int i, int nM, int nN, int& pm, int& pn) {
  const int nwg = nM * nN;
  const long L = (long)i * gridDim.x + blockIdx.x;
  if (L >= nwg) return false;
  int wgid = (int)L;
  { const int q = nwg / 8, r = nwg % 8, xcd = wgid % 8, off = wgid / 8; wgid = (xcd < r ? xcd * (q + 1) : r * (q + 1) + (xcd - r) * q) + off; }
  const int nig = 4 * nN, gid = wgid / nig, fm = gid * 4, gsz = (nM - fm) < 4 ? (nM - fm) : 4;
  pm = fm + ((wgid % nig) % gsz); pn = (wgid % nig) / gsz;
  return true;
}
template <class Epi>
DI void gemm_phase(LAS unsigned char* lds, const bf16_t* A, const bf16_t* Bt, int M, int N, int K, const Epi& epi) {
  const int nM = M / BM, nN = N / BM;
  int pm, pn;
  if (!gemm_unit(0, nM, nN, pm, pn)) return;
  for (int i = 0;; ++i) {
    int npm = 0, npn = 0;
    const bool have_next = gemm_unit(i + 1, nM, nN, npm, npn);
    gemm_tile(lds, A, Bt, K, pm, pn, epi, i == 0, have_next, npm, npn);
    if (!have_next) break;
    pm = npm; pn = npn;
  }
}

#define EPI_FENCE asm volatile("" ::: "memory")
constexpr int EQ_GN = 136192, EQ_CS = 136448, EQ_CSS = 272;
struct EpiQKV {
  static constexpr bool RSTD = true, ROPE = true;
  bf16_t* qkv; const float* ss; const float* qg; const float* kg; const float* cosT; const float* sinT;
  DI void pre_load(f32x4& r0, f32x4& r1, float& g, int brow, int pn, int tid) const {
    const int type = (pn % 12) >> 2, gi = pn / 12;
    const int c = 2 * tid, tr = c >> 4, q = c & 15;
    const size_t s = (size_t)(brow + (tr >> 5) * 64 + (tr & 31));
    const float* src = (q < 8) ? (cosT + s * 32 + 4 * q) : (sinT + s * 32 + 4 * (q - 8));
    r0 = *(const f32x4*)src; r1 = *(const f32x4*)(src + 4);
    g = ((type == 0) ? qg : kg)[gi * 64 + (tid & 63)];
  }
  DI void pre_store(LAS unsigned char* lds, const f32x4& r0, const f32x4& r1, float g, int tid) const {
    const int c = 2 * tid, tr = c >> 4, q = c & 15;
    *(LAS f32x4*)(lds + EQ_CS + tr * EQ_CSS + q * 16) = r0;
    *(LAS f32x4*)(lds + EQ_CS + tr * EQ_CSS + q * 16 + 16) = r1;
    if (tid < 64) ((LAS float*)(lds + EQ_GN))[tid] = g;
  }
  DI void operator()(LAS unsigned char* lds, f32x4 (&acc)[2][2][4][2], int pm, int pn, int wr, int wc, int fr, int fq) const {
    const int g = pn / 12, type = (pn % 12) >> 2, head = (pn & 3) * 4 + wc;
    bf16_t* base = qkv + (size_t)((g * 3 + type) * 16 + head) * S_LEN * 64;
    const float* gp = (type == 0 ? qg : kg) + g * 64;
    const int s0 = pm * BM + wr * 64 + fr;
    float rstd[2][4];
#pragma unroll
    for (int ai = 0; ai < 2; ++ai)
#pragma unroll
      for (int m = 0; m < 4; ++m) rstd[ai][m] = ((const LAS float*)(lds + 135168))[ai * HALF + wr * 64 + m * 16 + fr];
    f32x4 g1[2], g2[2];
    if (type < 2) {
#pragma unroll
      for (int n = 0; n < 2; ++n) { g1[n] = *(const LAS f32x4*)(lds + EQ_GN + (8 * fq + 4 * n) * 4); g2[n] = *(const LAS f32x4*)(lds + EQ_GN + (32 + 8 * fq + 4 * n) * 4); }
    }
#pragma unroll
    for (int aim = 0; aim < 4; ++aim) {
      const int ai = aim >> 1, mb = (aim & 1) * 2;
      f32x4 cs[4][2], sn[4][2];
      if (type < 2) {
#pragma unroll
        for (int m = mb; m < mb + 2; ++m)
#pragma unroll
          for (int n = 0; n < 2; ++n) {
            if (aim == 0) {
              const int tr = wr * 32 + m * 16 + fr;
              cs[m][n] = *(const LAS f32x4*)(lds + EQ_CS + tr * EQ_CSS + (8 * fq + 4 * n) * 4);
              sn[m][n] = *(const LAS f32x4*)(lds + EQ_CS + tr * EQ_CSS + 128 + (8 * fq + 4 * n) * 4);
            } else {
              const size_t o = (size_t)(s0 + ai * HALF + m * 16) * 32 + 8 * fq + 4 * n;
              cs[m][n] = *(const f32x4*)(cosT + o); sn[m][n] = *(const f32x4*)(sinT + o);
            }
          }
      }
      EPI_FENCE;
#pragma unroll
      for (int m = mb; m < mb + 2; ++m) {
        const int s = s0 + ai * HALF + m * 16;
        f32x4 v[2][2];
#pragma unroll
        for (int bj = 0; bj < 2; ++bj)
#pragma unroll
          for (int n = 0; n < 2; ++n) v[bj][n] = acc[ai][bj][m][n] * rstd[ai][m];
        if (type < 2) {
          float q = 0.f;
#pragma unroll
          for (int bj = 0; bj < 2; ++bj)
#pragma unroll
            for (int n = 0; n < 2; ++n) q += v[bj][n][0] * v[bj][n][0] + v[bj][n][1] * v[bj][n][1] + v[bj][n][2] * v[bj][n][2] + v[bj][n][3] * v[bj][n][3];
          q += __shfl_xor(q, 16); q += __shfl_xor(q, 32);
          float rn = rsqrtf(q * (1.0f / 64.0f) + EPS);
          if (type == 0) rn *= 0.125f * LOG2E;
#pragma unroll
          for (int n = 0; n < 2; ++n) {
            const f32x4 x1 = v[0][n] * g1[n] * rn, x2 = v[1][n] * g2[n] * rn;
            v[0][n] = x1 * cs[m][n] - x2 * sn[m][n]; v[1][n] = x2 * cs[m][n] + x1 * sn[m][n];
          }
        }
        bf16_t* rp = base + (size_t)s * 64 + 8 * fq;
#pragma unroll
        for (int bj = 0; bj < 2; ++bj) {
          u32x4 w; w.x = cvt_pk(v[bj][0][0], v[bj][0][1]); w.y = cvt_pk(v[bj][0][2], v[bj][0][3]); w.z = cvt_pk(v[bj][1][0], v[bj][1][1]); w.w = cvt_pk(v[bj][1][2], v[bj][1][3]);
          *(u32x4*)(rp + bj * 32) = w;
        }
      }
      EPI_FENCE;
    }
  }
};
struct EpiRes {
  static constexpr bool RSTD = false, ROPE = false;
  const float* resid; float* hout; bf16_t* hb; float* ssn;
  DI void operator()(LAS unsigned char* lds, f32x4 (&acc)[2][2][4][2], int pm, int pn, int wr, int wc, int fr, int fq) const {
    const size_t base0 = (size_t)(pm * BM + wr * 64 + fr) * DM + pn * BM + wc * 32 + fq * 4;
    LAS float* red = (LAS float*)(lds + 131072);
#pragma unroll
    for (int ai = 0; ai < 2; ++ai) {
      f32x4 rv[4][2][2];
#pragma unroll
      for (int m = 0; m < 4; ++m)
#pragma unroll
        for (int bj = 0; bj < 2; ++bj)
#pragma unroll
          for (int n = 0; n < 2; ++n) rv[m][bj][n] = *(const f32x4*)(resid + base0 + (size_t)(ai * HALF + m * 16) * DM + bj * HALF + n * 16);
      EPI_FENCE;
#pragma unroll
      for (int m = 0; m < 4; ++m) {
        const size_t off0 = base0 + (size_t)(ai * HALF + m * 16) * DM;
        float* op = hout + off0; bf16_t* bp = hb + off0;
        float q = 0.f;
#pragma unroll
        for (int bj = 0; bj < 2; ++bj)
#pragma unroll
          for (int n = 0; n < 2; ++n) {
            const f32x4 o = rv[m][bj][n] + acc[ai][bj][m][n];
            *(f32x4*)(op + bj * HALF + n * 16) = o;
            q += o[0] * o[0] + o[1] * o[1] + o[2] * o[2] + o[3] * o[3];
            u32x2 w; w.x = cvt_pk(o[0], o[1]); w.y = cvt_pk(o[2], o[3]);
            *(u32x2*)(bp + bj * HALF + n * 16) = w;
          }
        q += __shfl_xor(q, 16); q += __shfl_xor(q, 32);
        if (fq == 0) red[(ai * HALF + wr * 64 + m * 16 + fr) * 4 + wc] = q;
      }
      EPI_FENCE;
    }
    LBAR_;
    if (ssn) {
      const int t = threadIdx.x;
      if (t < 256) { const f32x4 p = *(const LAS f32x4*)(red + t * 4); ssn[(size_t)(pm * BM + t) * 4 + pn] = (p[0] + p[1]) + (p[2] + p[3]); }
    }
  }
};
struct EpiSwiglu {
  static constexpr bool RSTD = true, ROPE = false;
  bf16_t* act; const float* ss;
  DI void operator()(LAS unsigned char* lds, f32x4 (&acc)[2][2][4][2], int pm, int pn, int wr, int wc, int fr, int fq) const {
    const size_t r0 = (size_t)(pm * BM + wr * 64 + fr);
#pragma unroll
    for (int ai = 0; ai < 2; ++ai)
#pragma unroll
      for (int m = 0; m < 4; ++m) {
        const size_t row = r0 + ai * HALF + m * 16;
        const float rstd = ((const LAS float*)(lds + 135168))[ai * HALF + wr * 64 + m * 16 + fr];
        float o[8];
#pragma unroll
        for (int n = 0; n < 2; ++n)
#pragma unroll
          for (int j = 0; j < 4; ++j) {
            const float gg = acc[ai][0][m][n][j] * rstd, uu = acc[ai][1][m][n][j] * rstd;
            o[n * 4 + j] = gg * fast_rcp(1.0f + fast_exp(-gg)) * uu;
          }
        u32x4 w; w.x = cvt_pk(o[0], o[1]); w.y = cvt_pk(o[2], o[3]); w.z = cvt_pk(o[4], o[5]); w.w = cvt_pk(o[6], o[7]);
        *(u32x4*)(act + row * FFN_H + pn * 128 + wc * 32 + 8 * fq) = w;
      }
  }
};
struct EpiProj {
  static constexpr bool RSTD = true, ROPE = false;
  bf16_t* proj; float* zbuf; const float* ss;
  DI void operator()(LAS unsigned char* lds, f32x4 (&acc)[2][2][4][2], int pm, int pn, int wr, int wc, int fr, int fq) const {
    const size_t r0 = (size_t)(pm * BM + wr * 64 + fr);
#pragma unroll
    for (int ai = 0; ai < 2; ++ai)
#pragma unroll
      for (int m = 0; m < 4; ++m) {
        const size_t row = r0 + ai * HALF + m * 16;
        const float rstd = ((const LAS float*)(lds + 135168))[ai * HALF + wr * 64 + m * 16 + fr];
        if (pn < 12) {
#pragma unroll
          for (int bj = 0; bj < 2; ++bj) {
            const f32x4 a = acc[ai][bj][m][0] * rstd, b = acc[ai][bj][m][1] * rstd;
            u32x4 w; w.x = cvt_pk(a[0], a[1]); w.y = cvt_pk(a[2], a[3]); w.z = cvt_pk(b[0], b[1]); w.w = cvt_pk(b[2], b[3]);
            *(u32x4*)(proj + row * 3072 + pn * BM + bj * HALF + wc * 32 + 8 * fq) = w;
          }
        } else if (wc == 0) {
          *(f32x4*)(zbuf + row * 32 + 8 * fq) = acc[ai][0][m][0] * rstd;
          *(f32x4*)(zbuf + row * 32 + 8 * fq + 4) = acc[ai][0][m][1] * rstd;
        }
      }
  }
};

struct ConvJob { const float* src; bf16_t* dst; const float* gain; int K, Nsrc, Ndst, mode; };
DI void conv_tile(LAS unsigned char* lds, const ConvJob& J, int t) {
  LAS float* tile = (LAS float*)lds;
  const int tid = otid();
  const int nkt = J.K / 64, nt_ = t / nkt, kt = t % nkt;
  const int nn = tid & 255, np = nt_ * 256 + nn;
  int src; float cs = 1.f;
  if (J.mode == 0) src = np;
  else if (J.mode == 1) { const int r = np & 255; src = (np & ~255) + ((r >> 5) & 3) * 64 + (r >> 7) * 32 + perm32(r & 31); }
  else if (J.mode == 2) { const int r = np & 255; src = (r >> 7) * FFN_H + (np >> 8) * 128 + ((r >> 5) & 3) * 32 + perm32(r & 31); }
  else { src = (np & ~31) + perm32(np & 31); if (src < 512) cs = 0.08838834764831845f; if (src >= 3104) src = -1; }
  float v[32];
#pragma unroll
  for (int e = 0; e < 32; ++e) {
    const int k = kt * 64 + (tid >> 8) + 2 * e;
    v[e] = (src >= 0) ? J.src[(size_t)k * J.Nsrc + src] : 0.f;
  }
  if (J.gain) {
#pragma unroll
    for (int e = 0; e < 32; ++e) v[e] *= J.gain[kt * 64 + (tid >> 8) + 2 * e];
  }
  __syncthreads();
#pragma unroll
  for (int e = 0; e < 32; ++e) tile[((tid >> 8) + 2 * e) * 257 + nn] = v[e] * cs;
  __syncthreads();
#pragma unroll
  for (int p = 0; p < 4; ++p) {
    const int n2 = (tid >> 3) + 64 * p, kc = tid & 7;
    float f[8];
#pragma unroll
    for (int j = 0; j < 8; ++j) f[j] = tile[(kc * 8 + j) * 257 + n2];
    u32x4 w; w.x = cvt_pk(f[0], f[1]); w.y = cvt_pk(f[2], f[3]); w.z = cvt_pk(f[4], f[5]); w.w = cvt_pk(f[6], f[7]);
    *(u32x4*)(J.dst + (size_t)(nt_ * 256 + n2) * J.K + kt * 64 + kc * 8) = w;
  }
}
DI void convert_layer(const Params& P, LAS unsigned char* lds, int li) {
  bf16_t* W = (bf16_t*)(P.ws + OFF_W0 + (size_t)(li & 1) * W_BYTES);
  const int j = li >> 1;
  ConvJob J[4];
  if ((li & 1) == 0) {
    J[0] = ConvJob{P.in[3] + (size_t)j * DM * 9216, W + W_IN, P.in[1] + li * DM, DM, 9216, 9216, 1};
    J[1] = ConvJob{P.in[6] + (size_t)j * DM * DM, W + W_OUT, nullptr, DM, DM, DM, 0};
  } else {
    J[0] = ConvJob{P.in[7] + (size_t)j * DM * 3104, W + W_IN, P.in[1] + li * DM, DM, 3104, 3328, 3};
    J[1] = ConvJob{P.in[13] + (size_t)j * DM * DM, W + W_OUT, nullptr, DM, DM, DM, 0};
  }
  J[2] = ConvJob{P.in[14] + (size_t)li * DM * 2 * FFN_H, W + W_GU, P.in[2] + li * DM, DM, 2 * FFN_H, 2 * FFN_H, 2};
  J[3] = ConvJob{P.in[15] + (size_t)li * FFN_H * DM, W + W_DN, nullptr, FFN_H, DM, DM, 0};
  int cnt[4], tot = 0;
#pragma unroll
  for (int q = 0; q < 4; ++q) { cnt[q] = (J[q].Ndst / 256) * (J[q].K / 64); tot += cnt[q]; }
  for (int t = blockIdx.x; t < tot; t += gridDim.x) {
    int tt = t;
    if (tt < cnt[0]) { conv_tile(lds, J[0], tt); continue; } tt -= cnt[0];
    if (tt < cnt[1]) { conv_tile(lds, J[1], tt); continue; } tt -= cnt[1];
    if (tt < cnt[2]) { conv_tile(lds, J[2], tt); continue; } tt -= cnt[2];
    conv_tile(lds, J[3], tt);
  }
  __syncthreads();
}

DI void prep_phase(const Params& P, LAS unsigned char* lds) {
  const int tid = otid(), wid = tid >> 6, lane = tid & 63;
  const float* x = P.in[0];
  bf16_t* hb = (bf16_t*)(P.ws + OFF_HB);
  float* ss = (float*)(P.ws + OFF_SS);
  for (int row = blockIdx.x * 8 + wid; row < T_TOK; row += gridDim.x * 8) {
    const float* xr = x + (size_t)row * DM;
    float q = 0.f;
#pragma unroll
    for (int e = 0; e < 4; ++e) {
      const f32x4 v = *(const f32x4*)(xr + e * 256 + lane * 4);
      q += v[0] * v[0] + v[1] * v[1] + v[2] * v[2] + v[3] * v[3];
      u32x2 w; w.x = cvt_pk(v[0], v[1]); w.y = cvt_pk(v[2], v[3]);
      *(u32x2*)(hb + (size_t)row * DM + e * 256 + lane * 4) = w;
    }
#pragma unroll
    for (int o = 1; o < 64; o <<= 1) q += __shfl_xor(q, o);
    if (lane < 4) ss[(size_t)row * 4 + lane] = (lane == 0) ? q : 0.f;
  }
  const int gtid = blockIdx.x * 512 + tid, gn = gridDim.x * 512;
  float* cosT = (float*)(P.ws + OFF_COS); float* sinT = (float*)(P.ws + OFF_SIN);
  for (int i = gtid; i < S_LEN * 32; i += gn) {
    const int s = i >> 5, fi = i & 31;
    double f = 1.0;
    for (int k = 0; k < fi; ++k) f *= 0.7498942093324559;
    double rev = (double)s * f * 0.15915494309189535;
    rev -= __builtin_rint(rev);
    cosT[i] = __builtin_amdgcn_cosf((float)rev);
    sinT[i] = __builtin_amdgcn_sinf((float)rev);
  }
  convert_layer(P, lds, 0);
}

constexpr int AT_STR = 144, AT_VOFF = 416 * AT_STR;
#define LBAR do { asm volatile("s_waitcnt lgkmcnt(0)" ::: "memory"); __builtin_amdgcn_s_barrier(); asm volatile("" ::: "memory"); } while (0)
DI void attn_phase(const Params& P, LAS unsigned char* lds, int b) {
  const int tid = otid(), wid = tid >> 6, lane = tid & 63, fr = lane & 15, fq = lane >> 4;
  const bf16_t* qkv = (const bf16_t*)(P.ws + OFF_QKV);
  bf16_t* aout = (bf16_t*)(P.ws + OFF_AOUT) + (size_t)b * S_LEN * DM;
  float* lse = (float*)(P.ws + OFF_LSE);
  __syncthreads();
  for (int i = tid; i < 32 * AT_STR / 4; i += 512) { ((LAS unsigned*)(lds + 384 * AT_STR))[i] = 0u; ((LAS unsigned*)(lds + AT_VOFF + 384 * AT_STR))[i] = 0u; }
  for (int item = blockIdx.x; item < 256; item += gridDim.x) {
    const int tile = item >> 4, head = item & 15, T0 = tile * 1024;
    for (int g = 0; g < 3; ++g) {
      const int lg = 2 * g, dil = 1 << lg, L = S_LEN >> lg;
      const int NP = (g == 2) ? 2 : 1, WR = 384 / NP, NQ = (g < 2) ? 2 : 1, nrounds = (g < 2) ? 4 : 8;
      const bf16_t* Qg = qkv + (size_t)((g * 3 + 0) * 16 + head) * S_LEN * 64;
      const bf16_t* Kg = qkv + (size_t)((g * 3 + 1) * 16 + head) * S_LEN * 64;
      const bf16_t* Vg = qkv + (size_t)((g * 3 + 2) * 16 + head) * S_LEN * 64;
      u32x4 pk[6], pv[6];
#define AT_LOAD(RD) do { int pb_, p0_; if (g == 0) { pb_ = 0; p0_ = T0 + 256 * (RD); } else if (g == 1) { pb_ = (RD); p0_ = T0 >> 2; } else { pb_ = 2 * (RD); p0_ = T0 >> 4; } \
        _Pragma("unroll") for (int e = 0; e < 6; ++e) { const int idx = tid + e * 512, row = idx >> 3, ch = idx & 7; \
          const int slab = (row >= WR) ? 1 : 0, rr = row - slab * WR; const int pos = p0_ - 64 + rr, tok = pos * dil + pb_ + slab; \
          pk[e] = (u32x4){0u, 0u, 0u, 0u}; pv[e] = pk[e]; \
          if (pos >= 0 && pos < L) { pk[e] = *(const u32x4*)(Kg + (size_t)tok * 64 + ch * 8); pv[e] = *(const u32x4*)(Vg + (size_t)tok * 64 + ch * 8); } } } while (0)
      AT_LOAD(0);
      for (int rd = 0; rd < nrounds; ++rd) {
        const int tid = otid(), wid = tid >> 6, lane = tid & 63, fr = lane & 15, fq = lane >> 4;
        int pbase, P0;
        if (g == 0) { pbase = 0; P0 = T0 + 256 * rd; } else if (g == 1) { pbase = rd; P0 = T0 >> 2; } else { pbase = 2 * rd; P0 = T0 >> 4; }
        LBAR;
        if (rd == 0 && g > 0) asm volatile("buffer_inv sc1" ::: "memory");
#pragma unroll
        for (int e = 0; e < 6; ++e) {
          const int idx = tid + e * 512, row = idx >> 3, ch = idx & 7;
          *(LAS u32x4*)(lds + row * AT_STR + ch * 16) = pk[e];
          *(LAS u32x4*)(lds + AT_VOFF + row * AT_STR + ch * 16) = pv[e];
        }
        const int wl = (NP == 2) ? (wid & 3) : wid, slab = (NP == 2) ? (wid >> 2) : 0, phase = pbase + slab;
        const int i0 = P0 + 16 * NQ * wl, rowbase = slab * WR + 16 * NQ * wl;
        bf16x8 qf[2][2]; unsigned long long prev[2][4]; float plse[2];
#pragma unroll
        for (int q = 0; q < 2; ++q) {
          plse[q] = 0.f;
#pragma unroll
          for (int dt = 0; dt < 4; ++dt) prev[q][dt] = 0ull;
          if (q < NQ) {
            const int qtok = (i0 + 16 * q + fr) * dil + phase;
            qf[q][0] = *(const bf16x8*)(Qg + (size_t)qtok * 64 + fq * 8);
            qf[q][1] = *(const bf16x8*)(Qg + (size_t)qtok * 64 + 32 + fq * 8);
            if (g > 0) {
              plse[q] = lse[(size_t)qtok * 16 + head];
#pragma unroll
              for (int dt = 0; dt < 4; ++dt)
                prev[q][dt] = *(const unsigned long long*)(aout + (size_t)qtok * DM + head * 64 + 4 * fq + dt * 16);
            }
          } else { qf[q][0] = (bf16x8){0, 0, 0, 0, 0, 0, 0, 0}; qf[q][1] = qf[q][0]; }
        }
        LBAR;
        if (rd + 1 < nrounds) AT_LOAD(rd + 1);
        LAS unsigned char* kb = lds + (rowbase + fr) * AT_STR + fq * 16;
        LAS unsigned char* vb = lds + AT_VOFF + (rowbase + fq * 4 + (fr >> 2)) * AT_STR + (fr & 3) * 8;
        f32x4 sc[2][9];
#pragma unroll
        for (int t = 0; t < 10; ++t) {
          const bf16x8 k0 = *(const LAS bf16x8*)(kb + t * 16 * AT_STR), k1 = *(const LAS bf16x8*)(kb + t * 16 * AT_STR + 64);
          if (t < 9) { f32x4 a = (f32x4){0.f, 0.f, 0.f, 0.f}; a = mfma16(k0, qf[0][0], a); a = mfma16(k1, qf[0][1], a); sc[0][t] = a; }
          if (t > 0 && NQ == 2) { f32x4 a = (f32x4){0.f, 0.f, 0.f, 0.f}; a = mfma16(k0, qf[1][0], a); a = mfma16(k1, qf[1][1], a); sc[1][t - 1] = a; }
          if (t == 3 || t == 6) SCHED;
        }
        SCHED;
        const bool edge = (i0 < 64) || (i0 + 96 > L);
        float mxv[2], lsv[2];
#pragma unroll
        for (int q = 0; q < 2; ++q) {
          mxv[q] = 0.f; lsv[q] = 1.f;
          if (q < NQ) {
#pragma unroll
            for (int r = 0; r < 4; ++r) {
              if (4 * fq + r < fr) sc[q][0][r] = -3.0e38f;
              if (4 * fq + r > fr) sc[q][8][r] = -3.0e38f;
            }
            if (edge) {
#pragma unroll
              for (int tr = 0; tr < 9; ++tr)
#pragma unroll
                for (int r = 0; r < 4; ++r) { const int kpos = i0 - 64 + (q + tr) * 16 + 4 * fq + r; if (kpos < 0 || kpos >= L) sc[q][tr][r] = -3.0e38f; }
            }
            float mx = -3.0e38f;
#pragma unroll
            for (int tr = 0; tr < 9; ++tr) mx = fmaxf(mx, fmaxf(fmaxf(sc[q][tr][0], sc[q][tr][1]), fmaxf(sc[q][tr][2], sc[q][tr][3])));
            mx = fmaxf(mx, __shfl_xor(mx, 16)); mx = fmaxf(mx, __shfl_xor(mx, 32));
            float lsum = 0.f;
#pragma unroll
            for (int tr = 0; tr < 9; ++tr)
#pragma unroll
              for (int r = 0; r < 4; ++r) { const float p = fast_exp2(sc[q][tr][r] - mx); sc[q][tr][r] = p; lsum += p; }
            lsum += __shfl_xor(lsum, 16); lsum += __shfl_xor(lsum, 32);
            mxv[q] = mx; lsv[q] = lsum;
          }
        }
        f32x4 oacc[2][4];
#pragma unroll
        for (int q = 0; q < 2; ++q)
#pragma unroll
          for (int dt = 0; dt < 4; ++dt) oacc[q][dt] = (f32x4){0.f, 0.f, 0.f, 0.f};
#pragma unroll
        for (int ks = 0; ks < 5; ++ks) {
          bf16x8 pf0, pf1;
          {
            const unsigned a0 = cvt_pk(sc[0][2 * ks][0], sc[0][2 * ks][1]), a1 = cvt_pk(sc[0][2 * ks][2], sc[0][2 * ks][3]);
            unsigned b0 = 0u, b1 = 0u;
            if (ks < 4) { b0 = cvt_pk(sc[0][2 * ks + 1][0], sc[0][2 * ks + 1][1]); b1 = cvt_pk(sc[0][2 * ks + 1][2], sc[0][2 * ks + 1][3]); }
            u32x4 w = (u32x4){a0, a1, b0, b1}; pf0 = *(bf16x8*)&w; }
          pf1 = (bf16x8){0, 0, 0, 0, 0, 0, 0, 0};
          if (NQ == 2) {
            unsigned a0 = 0u, a1 = 0u;
            if (ks > 0) { a0 = cvt_pk(sc[1][2 * ks - 1][0], sc[1][2 * ks - 1][1]); a1 = cvt_pk(sc[1][2 * ks - 1][2], sc[1][2 * ks - 1][3]); }
            const unsigned b0 = cvt_pk(sc[1][2 * ks][0], sc[1][2 * ks][1]), b1 = cvt_pk(sc[1][2 * ks][2], sc[1][2 * ks][3]);
            u32x4 w = (u32x4){a0, a1, b0, b1}; pf1 = *(bf16x8*)&w; }
#pragma unroll
          for (int dt = 0; dt < 4; ++dt) {
            const bf16x8 vf = tr_pair(vb + (ks * 32) * AT_STR + dt * 32, vb + (ks * 32 + 16) * AT_STR + dt * 32);
            oacc[0][dt] = mfma16(vf, pf0, oacc[0][dt]);
            if (NQ == 2) oacc[1][dt] = mfma16(vf, pf1, oacc[1][dt]);
          }
          SCHED;
        }
#pragma unroll
        for (int q = 0; q < 2; ++q) {
          if (q < NQ) {
            const int qtok = (i0 + 16 * q + fr) * dil + phase;
            const float inv = fast_rcp(lsv[q]);
            float l2 = mxv[q] + fast_log2(lsv[q]);
            bf16_t* op = aout + (size_t)qtok * DM + head * 64 + 4 * fq;
            float* lp = lse + (size_t)qtok * 16 + head;
            float w2 = 1.f, w1 = 0.f;
            if (g > 0) {
              const float lr = plse[q];
              const float M = fmaxf(lr, l2);
              const float e1 = fast_exp2(lr - M), e2 = fast_exp2(l2 - M), isum = fast_rcp(e1 + e2);
              w1 = e1 * isum; w2 = e2 * isum; l2 = M + fast_log2(e1 + e2);
            }
#pragma unroll
            for (int dt = 0; dt < 4; ++dt) {
              f32x4 o = oacc[q][dt] * (inv * w2);
              if (g > 0) {
                const unsigned long long pvv = prev[q][dt];
                const unsigned lo = (unsigned)pvv, hi = (unsigned)(pvv >> 32);
                o[0] += w1 * __uint_as_float(lo << 16); o[1] += w1 * __uint_as_float(lo & 0xffff0000u);
                o[2] += w1 * __uint_as_float(hi << 16); o[3] += w1 * __uint_as_float(hi & 0xffff0000u);
              }
              u32x2 w; w.x = cvt_pk(o[0], o[1]); w.y = cvt_pk(o[2], o[3]);
              *(u32x2*)(op + dt * 16) = w;
            }
            if (fq == 0) *lp = l2;
          }
        }
      }
      asm volatile("s_waitcnt vmcnt(0)" ::: "memory");
    }
  }
  __syncthreads();
}

constexpr int GL_ST = 0, GL_STS = 272, GL_V = 69632, GL_VS = 544, GL_Q = GL_V + 64 * GL_VS  , GL_QS = 272, GL_K = GL_Q + 64 * GL_QS  ,
              GL_A = GL_K + 64 * GL_QS  , GL_AS = 144, GL_TOT = GL_A + 64 * GL_AS  , GL_DEC = GL_TOT + 2048, GL_RED = GL_DEC + 512;
static_assert(GL_RED + 2048 <= LDS_BYTES, "lds");

DI float logsig16(float z) { return (fminf(z, 0.f) - __logf(1.0f + __expf(-fabsf(z)))) * (1.0f / 16.0f); }
DI void gla_gate_phase(const Params& P, LAS unsigned char* lds, int lj) {
  const int tid = otid(), h = tid >> 7, dcol = tid & 127, col = h * 128 + dcol;
  bf16_t* proj = (bf16_t*)(P.ws + OFF_PROJ);
  const float* zbuf = (const float*)(P.ws + OFF_Z);
  bf16_t* QB = (bf16_t*)(P.ws + OFF_HB); bf16_t* KB = QB + (size_t)T_TOK * 512;
  float* dect = (float*)(P.ws + OFF_DEC);
  const float* Wf = P.in[8] + (size_t)lj * 16 * 512; const float* Wb = P.in[10] + (size_t)lj * 16 * 512;
  float wf[16], wb[16];
#pragma unroll
  for (int j = 0; j < 16; ++j) { wf[j] = Wf[j * 512 + col]; wb[j] = Wb[j * 512 + col]; }
  const float bf_ = P.in[9][(size_t)lj * 512 + col], bb_ = P.in[11][(size_t)lj * 512 + col];
  LAS float* zL = (LAS float*)lds;
  for (int item = blockIdx.x; item < 512; item += gridDim.x) {
    __syncthreads();
    { const int row = tid >> 3, part = tid & 7; *(LAS f32x4*)(zL + row * 32 + part * 4) = *(const f32x4*)(zbuf + ((size_t)item * 64 + row) * 32 + part * 4); }
    __syncthreads();
    float lsb[64]; float totb = 0.f;
#pragma unroll
    for (int i = 0; i < 64; ++i) {
      float z = bb_;
#pragma unroll
      for (int j4 = 0; j4 < 4; ++j4) { const f32x4 zz = *(const LAS f32x4*)(zL + i * 32 + 16 + j4 * 4); z += zz[0] * wb[j4 * 4] + zz[1] * wb[j4 * 4 + 1] + zz[2] * wb[j4 * 4 + 2] + zz[3] * wb[j4 * 4 + 3]; }
      lsb[i] = logsig16(z); totb += lsb[i];
    }
    float runf = 0.f, runb = 0.f;
#pragma unroll
    for (int ib = 0; ib < 4; ++ib) {
      bf16_t qraw[16], kraw[16];
#pragma unroll
      for (int ii = 0; ii < 16; ++ii) { const bf16_t* pr = proj + ((size_t)item * 64 + ib * 16 + ii) * 3072 + col; qraw[ii] = pr[0]; kraw[ii] = pr[512]; }
      asm volatile("" ::: "memory");
#pragma unroll
      for (int ii = 0; ii < 16; ++ii) {
        const int i = ib * 16 + ii;
        float z = bf_;
#pragma unroll
        for (int j4 = 0; j4 < 4; ++j4) { const f32x4 zz = *(const LAS f32x4*)(zL + i * 32 + j4 * 4); z += zz[0] * wf[j4 * 4] + zz[1] * wf[j4 * 4 + 1] + zz[2] * wf[j4 * 4 + 2] + zz[3] * wf[j4 * 4 + 3]; }
        runf += logsig16(z);
        const float Bi = totb - runb; runb += lsb[i];
        const size_t tokrow = (size_t)item * 64 + i;
        bf16_t* pr = proj + tokrow * 3072 + col;
        const float q = bf2f(qraw[ii]), k = bf2f(kraw[ii]);
        pr[0] = f2bf(q * __expf(runf)); pr[512] = f2bf(k * __expf(-runf));
        QB[tokrow * 512 + col] = f2bf(q * __expf(Bi)); KB[tokrow * 512 + col] = f2bf(k * __expf(-Bi));
      }
      asm volatile("" ::: "memory");
    }
    dect[(size_t)item * 512 + col] = __expf(runf);
    dect[(size_t)(512 + item) * 512 + col] = __expf(totb);
  }
  __syncthreads();
}

template <int MODE>
DI void gla_walk(const Params& P, LAS unsigned char* lds, int lj, int b, int h, int dir, int seg, f32x4 (&accS)[8][2], float& dprod) {
  const bf16_t* proj = (const bf16_t*)(P.ws + OFF_PROJ);
  bf16_t* gated = (bf16_t*)(P.ws + OFF_GATED);
  const float* dect = (const float*)(P.ws + OFF_DEC) + (size_t)dir * 512 * 512 + (size_t)b * 256 * 512 + h * 128;
  const float* ogain = P.in[12] + (size_t)lj * 1024 + h * 256;
  const size_t tokbase = (size_t)b * S_LEN;
  const int qstr = dir ? 512 : 3072;
  const bf16_t* qsrc = (dir ? (const bf16_t*)(P.ws + OFF_HB) + h * 128 : proj + h * 128) + tokbase * qstr;
  const bf16_t* ksrc = (dir ? (const bf16_t*)(P.ws + OFF_HB) + (size_t)T_TOK * 512 + h * 128 : proj + 512 + h * 128) + tokbase * qstr;
  const bf16_t* vsrc = proj + 1024 + h * 256 + tokbase * 3072;
  bf16_t* gbase = gated + tokbase * DM + h * 256;
  const bf16_t* rbase = proj + tokbase * 3072 + 2048 + h * 256;
  LAS float* DEC = (LAS float*)(lds + GL_DEC);
  LAS float* RED = (LAS float*)(lds + GL_RED);
  u32x4 pk[2], pq[2], pv[4]; float pdec = 1.f;
  f32x4 gnv[2];
  { const int t0_ = otid(); gnv[0] = *(const f32x4*)(ogain + (2 * (t0_ >> 6) + 0) * 16 + 4 * ((t0_ & 63) >> 4)); gnv[1] = *(const f32x4*)(ogain + (2 * (t0_ >> 6) + 1) * 16 + 4 * ((t0_ & 63) >> 4)); }
#define GL_LOAD(CC) do { const int t_ = otid(); const int ch_ = dir ? (seg * CPS + CPS - 1 - (CC)) : (seg * CPS + (CC)); const int c0_ = ch_ * 64; \
    _Pragma("unroll") for (int e = 0; e < 2; ++e) { const int idx = t_ + e * 512, i = idx >> 4, cx = idx & 15, tok = dir ? (c0_ + 63 - i) : (c0_ + i); \
      const unsigned o_ = (unsigned)(tok * qstr + cx * 8); pk[e] = *(const u32x4*)(ksrc + o_); if (MODE != 0) pq[e] = *(const u32x4*)(qsrc + o_); } \
    _Pragma("unroll") for (int e = 0; e < 4; ++e) { const int idx = t_ + e * 512, i = idx >> 5, cx = idx & 31, tok = dir ? (c0_ + 63 - i) : (c0_ + i); \
      pv[e] = *(const u32x4*)(vsrc + (unsigned)(tok * 3072 + cx * 8)); } \
    pdec = dect[(size_t)ch_ * 512 + (t_ & 127)]; } while (0)
  GL_LOAD(0);
  for (int cc = 0; cc < CPS; ++cc) {
    const int tid = otid(), wid = tid >> 6, lane = tid & 63, fr = lane & 15, fq = lane >> 4;
    const int c0 = (dir ? (seg * CPS + CPS - 1 - cc) : (seg * CPS + cc)) * 64;
    LBAR;
#pragma unroll
    for (int e = 0; e < 2; ++e) { const int idx = tid + e * 512, i = idx >> 4, cx = idx & 15;
      *(LAS u32x4*)(lds + GL_K + i * GL_QS + cx * 16) = pk[e]; if (MODE != 0) *(LAS u32x4*)(lds + GL_Q + i * GL_QS + cx * 16) = pq[e]; }
#pragma unroll
    for (int e = 0; e < 4; ++e) { const int idx = tid + e * 512, i = idx >> 5, cx = idx & 31; *(LAS u32x4*)(lds + GL_V + i * GL_VS + cx * 16) = pv[e]; }
    if (tid < 128) { DEC[tid] = pdec; dprod *= pdec; }
    LBAR;
    GL_LOAD((cc + 1 < CPS) ? cc + 1 : cc);
    unsigned long long pof[2][4]; u32x2 prv[2][4];
    if (MODE == 2) {
#pragma unroll
      for (int tt = 0; tt < 4; ++tt)
#pragma unroll
        for (int et2 = 0; et2 < 2; ++et2)
          prv[et2][tt] = *(const u32x2*)(rbase + (unsigned)((c0 + 63 - (tt * 16 + fr)) * 3072 + (2 * wid + et2) * 16 + 4 * fq));
#pragma unroll
      for (int tt = 0; tt < 4; ++tt)
#pragma unroll
        for (int et2 = 0; et2 < 2; ++et2)
          pof[et2][tt] = *(const unsigned long long*)(gbase + (unsigned)((c0 + 63 - (tt * 16 + fr)) * DM + (2 * wid + et2) * 16 + 4 * fq));
    }
    if (MODE != 0) {
      const int st = wid >> 1;
#pragma unroll
      for (int t2 = 0; t2 < 2; ++t2) {
        const int tt = 2 * (wid & 1) + t2;
        f32x4 a = (f32x4){0.f, 0.f, 0.f, 0.f};
        if (st <= tt) {
#pragma unroll
          for (int ks = 0; ks < 4; ++ks)
            a = mfma16(*(const LAS bf16x8*)(lds + GL_K + (st * 16 + fr) * GL_QS + ks * 64 + fq * 16),
                       *(const LAS bf16x8*)(lds + GL_Q + (tt * 16 + fr) * GL_QS + ks * 64 + fq * 16), a);
          const int tcol = tt * 16 + fr;
#pragma unroll
          for (int r = 0; r < 4; ++r) { const int s = st * 16 + 4 * fq + r; const bool keep = dir ? (s < tcol) : (s <= tcol); a[r] = keep ? a[r] : 0.f; }
        }
        u32x2 w; w.x = cvt_pk(a[0], a[1]); w.y = cvt_pk(a[2], a[3]);
        *(LAS u32x2*)(lds + GL_A + (tt * 16 + fr) * GL_AS + (st * 16 + 4 * fq) * 2) = w;
      }
      LBAR;
    }
    bf16x8 vf[2][2];
#pragma unroll
    for (int et2 = 0; et2 < 2; ++et2)
#pragma unroll
      for (int ks = 0; ks < 2; ++ks) {
        LAS unsigned char* p = lds + GL_V + (ks * 32 + 8 * fq + (fr >> 2)) * GL_VS + ((2 * wid + et2) * 16 + 4 * (fr & 3)) * 2;
        vf[et2][ks] = tr_pair(p, p + 4 * GL_VS);
      }
    if (MODE != 0) {
      f32x4 accO[2][4];
#pragma unroll
      for (int et2 = 0; et2 < 2; ++et2)
#pragma unroll
        for (int tt = 0; tt < 4; ++tt) accO[et2][tt] = (f32x4){0.f, 0.f, 0.f, 0.f};
#pragma unroll
      for (int tt = 0; tt < 4; ++tt) {
#pragma unroll
        for (int ks = 0; ks < 2; ++ks) {
          const bf16x8 af = *(const LAS bf16x8*)(lds + GL_A + (tt * 16 + fr) * GL_AS + ks * 64 + fq * 16);
          accO[0][tt] = mfma16(vf[0][ks], af, accO[0][tt]);
          accO[1][tt] = mfma16(vf[1][ks], af, accO[1][tt]);
        }
#pragma unroll
        for (int ks = 0; ks < 4; ++ks) {
          const bf16x8 qf = *(const LAS bf16x8*)(lds + GL_Q + (tt * 16 + fr) * GL_QS + ks * 64 + fq * 16);
#pragma unroll
          for (int et2 = 0; et2 < 2; ++et2) {
            const bf16x8 sf = *(const LAS bf16x8*)(lds + GL_ST + ((2 * wid + et2) * 16 + fr) * GL_STS + ks * 64 + fq * 16);
            accO[et2][tt] = mfma16(sf, qf, accO[et2][tt]);
          }
        }
        SCHED;
      }
      if (MODE == 1) {
#pragma unroll
        for (int tt = 0; tt < 4; ++tt) {
          const int t = tt * 16 + fr, tok = c0 + t;
#pragma unroll
          for (int et2 = 0; et2 < 2; ++et2) {
            u32x2 w; w.x = cvt_pk(accO[et2][tt][0], accO[et2][tt][1]); w.y = cvt_pk(accO[et2][tt][2], accO[et2][tt][3]);
            *(u32x2*)(gbase + (unsigned)(tok * DM + (2 * wid + et2) * 16 + 4 * fq)) = w;
          }
        }
      } else {
#pragma unroll
        for (int tt = 0; tt < 4; ++tt) {
          const int t = tt * 16 + fr;
          float q = 0.f;
#pragma unroll
          for (int et2 = 0; et2 < 2; ++et2) {
            const unsigned long long pvv = pof[et2][tt];
            const unsigned lo = (unsigned)pvv, hi = (unsigned)(pvv >> 32);
            f32x4 o = accO[et2][tt];
            o[0] += __uint_as_float(lo << 16); o[1] += __uint_as_float(lo & 0xffff0000u); o[2] += __uint_as_float(hi << 16); o[3] += __uint_as_float(hi & 0xffff0000u);
            accO[et2][tt] = o;
            q += o[0] * o[0] + o[1] * o[1] + o[2] * o[2] + o[3] * o[3];
          }
          q += __shfl_xor(q, 16); q += __shfl_xor(q, 32);
          if (fq == 0) RED[wid * 64 + t] = q;
        }
        LBAR;
#pragma unroll
        for (int tt = 0; tt < 4; ++tt) {
          const int t = tt * 16 + fr, tok = c0 + 63 - t;
          float q = 0.f;
#pragma unroll
          for (int w8 = 0; w8 < 8; ++w8) q += RED[w8 * 64 + t];
          const float rn = rsqrtf(q * (1.0f / 256.0f) + EPS);
#pragma unroll
          for (int et2 = 0; et2 < 2; ++et2) {
            const int e0 = (2 * wid + et2) * 16 + 4 * fq;
            const f32x4 gn = gnv[et2];
            const u32x2 rv = prv[et2][tt];
            float rr[4] = {__uint_as_float(rv.x << 16), __uint_as_float(rv.x & 0xffff0000u), __uint_as_float(rv.y << 16), __uint_as_float(rv.y & 0xffff0000u)};
            float o[4];
#pragma unroll
            for (int r = 0; r < 4; ++r) o[r] = accO[et2][tt][r] * rn * gn[r] * (rr[r] * fast_rcp(1.0f + fast_exp(-rr[r])));
            u32x2 w; w.x = cvt_pk(o[0], o[1]); w.y = cvt_pk(o[2], o[3]);
            *(u32x2*)(gbase + (unsigned)(tok * DM + e0)) = w;
          }
          SCHED;
        }
      }
    }
#pragma unroll
    for (int dt = 0; dt < 8; ++dt) {
#pragma unroll
      for (int ks = 0; ks < 2; ++ks) {
        LAS unsigned char* p = lds + GL_K + (ks * 32 + 8 * fq + (fr >> 2)) * GL_QS + (dt * 16 + 4 * (fr & 3)) * 2;
        const bf16x8 kf = tr_pair(p, p + 4 * GL_QS);
        accS[dt][0] = mfma16(kf, vf[0][ks], accS[dt][0]);
        accS[dt][1] = mfma16(kf, vf[1][ks], accS[dt][1]);
      }
      const f32x4 dc = *(const LAS f32x4*)(lds + GL_DEC + (dt * 16 + 4 * fq) * 4);
#pragma unroll
      for (int et2 = 0; et2 < 2; ++et2) {
        accS[dt][et2] = accS[dt][et2] * dc;
        if (MODE != 0) {
          u32x2 w; w.x = cvt_pk(accS[dt][et2][0], accS[dt][et2][1]); w.y = cvt_pk(accS[dt][et2][2], accS[dt][et2][3]);
          *(LAS u32x2*)(lds + GL_ST + ((2 * wid + et2) * 16 + fr) * GL_STS + (dt * 16 + 4 * fq) * 2) = w;
        }
      }
      if (dt & 1) SCHED;
    }
  }
  LBAR;
}

DI void gla_sum_phase(const Params& P, LAS unsigned char* lds, int lj) {
  const int tid = otid(), wid = tid >> 6, lane = tid & 63;
  float* state = (float*)(P.ws + OFF_STATE);
  float* dseg = (float*)(P.ws + OFF_DSEG);
  __syncthreads();
  for (int item = blockIdx.x; item < 16 * NSEG; item += gridDim.x) {
    const int seg = item % NSEG, dir = (item / NSEG) & 1, bh = item / (2 * NSEG);
    f32x4 accS[8][2];
#pragma unroll
    for (int dt = 0; dt < 8; ++dt) { accS[dt][0] = (f32x4){0.f, 0.f, 0.f, 0.f}; accS[dt][1] = accS[dt][0]; }
    float dprod = 1.f;
    gla_walk<0>(P, lds, lj, bh >> 2, bh & 3, dir, seg, accS, dprod);
    float* sp = state + ((size_t)(bh * 2 + dir) * NSEG + seg) * 32768 + wid * 4096 + lane;
#pragma unroll
    for (int dt = 0; dt < 8; ++dt)
#pragma unroll
      for (int et2 = 0; et2 < 2; ++et2)
#pragma unroll
        for (int r = 0; r < 4; ++r) sp[((dt * 2 + et2) * 4 + r) * 64] = accS[dt][et2][r];
    if (tid < 128) dseg[((size_t)(bh * 2 + dir) * NSEG + seg) * 128 + tid] = dprod;
  }
}
DI void gla_scan_phase(const Params& P) {
  float* state = (float*)(P.ws + OFF_STATE);
  const float* dseg = (const float*)(P.ws + OFF_DSEG);
  const int gtid = blockIdx.x * 512 + otid(), gn = gridDim.x * 512;
  for (int i = gtid; i < 16 * 32768; i += gn) {
    const int e = i & 32767, bd = i >> 15, dir = bd & 1;
    const int reg = (e >> 6) & 63, d = (reg >> 3) * 16 + 4 * ((e & 63) >> 4) + (reg & 3);
    float loc[NSEG], dc[NSEG];
#pragma unroll
    for (int s2 = 0; s2 < NSEG; ++s2) {
      const int seg = dir ? (NSEG - 1 - s2) : s2;
      loc[s2] = state[((size_t)bd * NSEG + seg) * 32768 + e];
      dc[s2] = dseg[((size_t)bd * NSEG + seg) * 128 + d];
    }
    float run = 0.f;
#pragma unroll
    for (int s2 = 0; s2 < NSEG; ++s2) {
      const int seg = dir ? (NSEG - 1 - s2) : s2;
      state[((size_t)bd * NSEG + seg) * 32768 + e] = run;
      run = dc[s2] * run + loc[s2];
    }
  }
}
DI void gla_load_state(const float* sp, LAS unsigned char* lds, f32x4 (&accS)[8][2], int wid, int fr, int fq) {
#pragma unroll
  for (int dt = 0; dt < 8; ++dt)
#pragma unroll
    for (int et2 = 0; et2 < 2; ++et2) {
#pragma unroll
      for (int r = 0; r < 4; ++r) accS[dt][et2][r] = sp[((dt * 2 + et2) * 4 + r) * 64];
      u32x2 w; w.x = cvt_pk(accS[dt][et2][0], accS[dt][et2][1]); w.y = cvt_pk(accS[dt][et2][2], accS[dt][et2][3]);
      *(LAS u32x2*)(lds + GL_ST + ((2 * wid + et2) * 16 + fr) * GL_STS + (dt * 16 + 4 * fq) * 2) = w;
    }
}
DI void gla_out_phase(const Params& P, LAS unsigned char* lds, int lj) {
  const float* state = (const float*)(P.ws + OFF_STATE);
  __syncthreads();
  for (int item = blockIdx.x; item < 8 * NSEG; item += gridDim.x) {
    const int seg = item % NSEG, bh = item / NSEG;
    {
      const int tid = otid(), wid = tid >> 6, lane = tid & 63, fr = lane & 15, fq = lane >> 4;
      f32x4 accS[8][2]; float dprod = 1.f;
      gla_load_state(state + ((size_t)(bh * 2 + 0) * NSEG + seg) * 32768 + wid * 4096 + lane, lds, accS, wid, fr, fq);
      gla_walk<1>(P, lds, lj, bh >> 2, bh & 3, 0, seg, accS, dprod);
    }
    asm volatile("s_waitcnt vmcnt(0)" ::: "memory");
    __syncthreads();
    asm volatile("buffer_inv sc1" ::: "memory");
    {
      const int tid = otid(), wid = tid >> 6, lane = tid & 63, fr = lane & 15, fq = lane >> 4;
      f32x4 accS[8][2]; float dprod = 1.f;
      gla_load_state(state + ((size_t)(bh * 2 + 1) * NSEG + seg) * 32768 + wid * 4096 + lane, lds, accS, wid, fr, fq);
      gla_walk<2>(P, lds, lj, bh >> 2, bh & 3, 1, seg, accS, dprod);
    }
    __syncthreads();
  }
}


#define XB_TMO      128
#define XB_XCNT(j)  (256  + 64 * (j))
#define XB_XSUB(j)  (1280 + 64 * (j))
#define XB_XGEN(j)  (2304 + 64 * (j))
#define XB_TOP      3328
#define XB_TOPGEN   3392
#define XCD_BAR_WORDS 3456
#define XB_SPIN_CAP (1u << 20)
DI unsigned xb_ld(unsigned* p)              { return __hip_atomic_load(p, __ATOMIC_RELAXED, __HIP_MEMORY_SCOPE_AGENT); }
DI unsigned xb_add(unsigned* p, unsigned v) { return __hip_atomic_fetch_add(p, v, __ATOMIC_RELAXED, __HIP_MEMORY_SCOPE_AGENT); }
DI unsigned xb_xcc_id() { return (unsigned)__builtin_amdgcn_s_getreg((3 << 11) | 20) & 0xFu; }
#define XB_SPIN(cond, bar) do { unsigned _sp = 0; while (cond) { __builtin_amdgcn_s_sleep(1); \
    if ((++_sp & 255u) == 0u) { if (xb_ld(&(bar)[XB_TMO])) break; if (_sp > XB_SPIN_CAP) { atomicAdd(&(bar)[XB_TMO], 1u); break; } } } } while (0)
struct XcdBarrier { unsigned* bar; unsigned x; volatile LAS unsigned* st; };
DI XcdBarrier xcd_barrier_post(unsigned* bar, volatile LAS unsigned* st) {
  XcdBarrier b; b.bar = bar; b.x = xb_xcc_id(); b.st = st;
  if (threadIdx.x == 0) (void)xb_add(&bar[XB_XCNT(b.x)], 1u);
  return b;
}
DI void xcd_barrier_complete(unsigned* bar, unsigned x, unsigned& nloc, unsigned& nx) {
  const unsigned G = gridDim.x * gridDim.y * gridDim.z;
  unsigned sum, cnt, mine, sp = 0u;
  for (;;) {
    sum = 0u; cnt = 0u; mine = 0u;
#pragma unroll
    for (unsigned j = 0; j < 16; ++j) { const unsigned c = xb_ld(&bar[XB_XCNT(j)]); sum += c; cnt += (c > 0u) ? 1u : 0u; mine = (j == x) ? c : mine; }
    if (sum == G) break;
    __builtin_amdgcn_s_sleep(1);
    if ((++sp & 255u) == 0u) { if (xb_ld(&bar[XB_TMO])) break; if (sp > XB_SPIN_CAP) { atomicAdd(&bar[XB_TMO], 1u); break; } }
  }
  nloc = mine > 0u ? mine : 1u; nx = cnt > 0u ? cnt : 1u;
}
DI void xcd_barrier(const XcdBarrier& b) {
  asm volatile("s_waitcnt vmcnt(0)" ::: "memory");
  __syncthreads();
  if (threadIdx.x == 0) {
    unsigned* bar = b.bar;
    __builtin_amdgcn_s_waitcnt(0);
    unsigned nloc = b.st[0], nx = b.st[1];
    if (nloc == 0u) { xcd_barrier_complete(bar, b.x, nloc, nx); b.st[0] = nloc; b.st[1] = nx; }
    const unsigned old = xb_add(&bar[XB_XSUB(b.x)], 1u);
    const unsigned gen = old / nloc;
    if (old + 1u == (gen + 1u) * nloc) {
      __builtin_amdgcn_fence(__ATOMIC_RELEASE, "agent");
      asm volatile("s_waitcnt vmcnt(0)" ::: "memory");
      const unsigned og = xb_add(&bar[XB_TOP], 1u);
      const unsigned tg = og / nx;
      if (og + 1u == (tg + 1u) * nx) xb_add(&bar[XB_TOPGEN], 1u);
      else XB_SPIN(xb_ld(&bar[XB_TOPGEN]) == tg, bar);
      __builtin_amdgcn_fence(__ATOMIC_ACQUIRE, "agent");
      xb_add(&bar[XB_XGEN(b.x)], 1u);
      asm volatile("s_waitcnt vmcnt(0)" ::: "memory");
    } else {
      XB_SPIN(xb_ld(&bar[XB_XGEN(b.x)]) == gen, bar);
      __builtin_amdgcn_fence(__ATOMIC_ACQUIRE, "agent");
      asm volatile("s_waitcnt vmcnt(0)" ::: "memory");
    }
  }
  __syncthreads();
}

#ifndef PM
#define PM 0xFFFF
#endif
DI void run_phase(const Params& P, LAS unsigned char* lds, int ph) {
  unsigned char* ws = P.ws;
  bf16_t* hb = (bf16_t*)(ws + OFF_HB);
  if (ph == 0) { if (PM & 1) prep_phase(P, lds); return; }
  int li, sub;
  if (ph < 8) { li = 0; sub = ph - 1; } else if (ph < 16) { li = 1; sub = ph - 8; } else if (ph < 23) { li = 2; sub = ph - 16; } else { li = 3; sub = ph - 23; }
  const int lj = li >> 1;
  const bool isB = (li & 1) != 0;
  const int kind = isB ? (sub < 5 ? 0 : sub - 4) : (sub < 4 ? 0 : sub - 3);
  const bf16_t* W = (const bf16_t*)(ws + OFF_W0 + (size_t)(li & 1) * W_BYTES);
  if (kind == 2) { if (!(PM & 2)) return;
    EpiSwiglu e{(bf16_t*)(ws + OFF_ACT), (const float*)(ws + OFF_SS + SS_BYTES)};
    gemm_phase(lds, hb, W + W_GU, T_TOK, 2 * FFN_H, DM, e);
  } else if (kind == 3) { if (!(PM & 4)) return;
    EpiRes e{P.out, P.out, hb, (li < 3) ? (float*)(ws + OFF_SS) : nullptr};
    gemm_phase(lds, (const bf16_t*)(ws + OFF_ACT), W + W_DN, T_TOK, DM, FFN_H, e);
  } else if (kind == 1) { if (!(PM & 4)) return;
    EpiRes e{(li == 0) ? P.in[0] : P.out, P.out, hb, (float*)(ws + OFF_SS + SS_BYTES)};
    const bf16_t* Ain = isB ? (const bf16_t*)(ws + OFF_GATED) : (const bf16_t*)(ws + OFF_AOUT);
    gemm_phase(lds, Ain, W + W_OUT, T_TOK, DM, DM, e);
    if (li < 3) convert_layer(P, lds, li + 1);
  } else if (!isB) {
    const int b = sub >> 1;
    if ((sub & 1) == 0) { if (!(PM & 8)) return;
      EpiQKV e{(bf16_t*)(ws + OFF_QKV), (const float*)(ws + OFF_SS) + (size_t)b * S_LEN * 4, P.in[4] + lj * 192, P.in[5] + lj * 192,
               (const float*)(ws + OFF_COS), (const float*)(ws + OFF_SIN)};
      gemm_phase(lds, hb + (size_t)b * S_LEN * DM, W + W_IN, S_LEN, 9216, DM, e);
    } else if (PM & 16) attn_phase(P, lds, b);
  } else {
    if (sub == 0) { if (!(PM & 32)) return;
      EpiProj e{(bf16_t*)(ws + OFF_PROJ), (float*)(ws + OFF_Z), (const float*)(ws + OFF_SS)};
      gemm_phase(lds, hb, W + W_IN, T_TOK, 3328, DM, e);
    } else if (sub == 1) { if (PM & 512) gla_gate_phase(P, lds, lj); }
    else if (sub == 2) { if (PM & 64) gla_sum_phase(P, lds, lj); }
    else if (sub == 3) { if (PM & 128) gla_scan_phase(P); }
    else if (PM & 256) gla_out_phase(P, lds, lj);
  }
}

__global__ void __launch_bounds__(512, 2) mega_fwd(Params P) {
  extern __shared__ __attribute__((aligned(16))) unsigned char lds_raw[];
  LAS unsigned char* lds = (LAS unsigned char*)lds_raw;
  cg::grid_group grid = cg::this_grid();
  volatile LAS unsigned* xst = (volatile LAS unsigned*)(lds + LDS_BYTES - 16);
  if (threadIdx.x == 0) { xst[0] = 0u; xst[1] = 0u; }
  __syncthreads();
  const XcdBarrier xb = xcd_barrier_post((unsigned*)(P.ws + OFF_BAR), xst);
  for (int ph = P.ph_lo; ph < P.ph_hi; ++ph) {
    if (ph > P.ph_lo) { if (ph == P.ph_lo + 1) grid.sync(); else xcd_barrier(xb); }
    run_phase(P, lds, ph);
  }
}

extern "C" void kernel_launch(void* const* d_in, const int* in_sizes, int n_in, void* d_out, int out_size, void* d_ws, size_t ws_size,
                              hipStream_t stream) {
  static int grid = 0;
  if (grid == 0) {
    int dev = 0, cus = 0, per_cu = 0;
    hipGetDevice(&dev);
    hipDeviceGetAttribute(&cus, hipDeviceAttributeMultiprocessorCount, dev);
    if (hipFuncSetAttribute((const void*)mega_fwd, hipFuncAttributeMaxDynamicSharedMemorySize, LDS_BYTES) != hipSuccess)
      fprintf(stderr, "kernel_launch: hipFuncSetAttribute failed\n");
    if (hipOccupancyMaxActiveBlocksPerMultiprocessor(&per_cu, (const void*)mega_fwd, 512, LDS_BYTES) != hipSuccess || per_cu < 1) {
      fprintf(stderr, "kernel_launch: occupancy query says %d\n", per_cu); per_cu = 1; (void)hipGetLastError();
    }
    grid = cus * per_cu;
    if (ws_size < WS_NEED) fprintf(stderr, "kernel_launch: workspace too small: %zu < %zu\n", ws_size, (size_t)WS_NEED);
  }
  Params p{};
  for (int i = 0; i < 16; ++i) p.in[i] = (const float*)d_in[i];
  p.out = (float*)d_out; p.ws = (unsigned char*)d_ws; p.ph_lo = 0; p.ph_hi = NPHASES;
  (void)hipMemsetAsync((unsigned char*)d_ws + OFF_BAR, 0, XCD_BAR_WORDS * sizeof(unsigned), stream);
  void* args[] = {&p};
  hipError_t e = hipLaunchCooperativeKernel((const void*)mega_fwd, dim3(grid), dim3(512), args, LDS_BYTES, stream);
  if (e != hipSuccess) fprintf(stderr, "kernel_launch: cooperative launch failed: %s (grid %d)\n", hipGetErrorString(e), grid);
}
```
